# Optimizing an MI355X kernel written in HIP

```python
import jax
import jax.numpy as jnp
from jax import lax
import numpy as np

D_MODEL = 1024
BATCH = 8
SEQ = 2048
DEPTH = 4

CTX_LEN = 256
GRID_W = 64
RMS_EPS = 1e-6
GLA_HEADS = 4
GLA_DK = 64
GLA_DV = 128
GLA_GATE_RANK = 16
GLA_GATE_NORM = 16.0
GLA_CHUNK = 64
SG_GROUPS = 4
SG_DIM = 128
SG_CHUNK = 128
FT_GROUPS = 4
FT_DIM = 64
MLA_HEADS = 6
MLA_NOPE = 128
MLA_ROPE = 64
MLA_V = 128
MLA_Q_RANK = 384
MLA_KV_RANK = 256
ROPE_BASE = 10000.0
ATTN_BLOCK = 128
MIX_W = GLA_HEADS * GLA_DV + SG_GROUPS * SG_DIM
FFN_HIDDEN = -(-8 * D_MODEL // (3 * 256)) * 256
EV_SIZES = (GLA_HEADS * GLA_DK, GLA_HEADS * GLA_DK, GLA_HEADS * GLA_DV, GLA_HEADS * GLA_DV,
            GLA_GATE_RANK, GLA_GATE_RANK, SG_GROUPS * SG_DIM, SG_GROUPS * SG_DIM)
EV_IN_W = 2 * GLA_HEADS * GLA_DK + 2 * GLA_HEADS * GLA_DV + 2 * GLA_GATE_RANK + 2 * SG_GROUPS * SG_DIM
OD_SIZES = (FT_GROUPS * FT_DIM, MLA_Q_RANK, MLA_KV_RANK, MLA_ROPE)
OD_IN_W = FT_GROUPS * FT_DIM + MLA_Q_RANK + MLA_KV_RANK + MLA_ROPE
OD_KV_COL0 = FT_GROUPS * FT_DIM + MLA_Q_RANK

kernel_name = "hybrid_gla_gmlp_fnet_mla_flow_block"


def rms_norm(x, g):
    xf = x.astype(jnp.float32)
    y = xf * lax.rsqrt(jnp.mean(xf * xf, axis=-1, keepdims=True) + RMS_EPS)
    return (y * g.astype(jnp.float32)).astype(x.dtype)


def split_cols(p, sizes):
    out, start = [], 0
    for s in sizes:
        out.append(p[..., start:start + s])
        start += s
    return out


def split_mod(m):
    return [t[:, None, :] for t in jnp.split(m, 6, axis=-1)]


def modulate(h, shift, scale):
    return h * (1.0 + scale) + shift


def swiglu(h, w_in, w_out):
    gu = h @ w_in
    return (jax.nn.silu(gu[..., :FFN_HIDDEN]) * gu[..., FFN_HIDDEN:]) @ w_out


def axial_rope(n_tok):
    rows = n_tok // GRID_W
    row_id = jnp.repeat(jnp.arange(rows, dtype=jnp.float32), GRID_W)
    col_id = jnp.tile(jnp.arange(GRID_W, dtype=jnp.float32), rows)
    axis_dim = MLA_ROPE // 2
    inv_freq = ROPE_BASE ** (-jnp.arange(0, axis_dim, 2, dtype=jnp.float32) / axis_dim)
    ang_r = row_id[:, None] * inv_freq
    ang_c = col_id[:, None] * inv_freq
    ang = jnp.concatenate([ang_r, ang_r, ang_c, ang_c], axis=-1)
    return jnp.cos(ang), jnp.sin(ang)


def apply_axial_rope(t, cos, sin):
    quarter = MLA_ROPE // 4
    blocks = t.reshape(*t.shape[:-1], 2, 2, quarter)
    rot = jnp.stack([-blocks[..., 1, :], blocks[..., 0, :]], axis=-2).reshape(t.shape)
    return t * cos[:, None, :] + rot * sin[:, None, :]


def rope_tail(t, rope):
    cos, sin = rope
    cos, sin = cos.astype(t.dtype), sin.astype(t.dtype)
    return jnp.concatenate([t[..., :MLA_NOPE], apply_axial_rope(t[..., MLA_NOPE:], cos, sin)], axis=-1)


def gla_chunk_scan(q, k, v, g, s0):
    B_, L, H, _ = q.shape
    dv = v.shape[-1]
    n = L // GLA_CHUNK

    def to_chunks(t):
        return t.reshape(B_, n, GLA_CHUNK, H, t.shape[-1]).transpose(1, 0, 3, 2, 4)

    causal = jnp.tril(jnp.ones((GLA_CHUNK, GLA_CHUNK), dtype=bool))

    def step(S, inp):
        qi, ki, vi, gi = inp
        b = jnp.cumsum(gi, axis=2)
        o_inter = jnp.einsum('bhtk,bhkv->bhtv', qi * jnp.exp(b), S)
        diff = b[:, :, :, None, :] - b[:, :, None, :, :]
        decay = jnp.exp(jnp.where(causal[:, :, None], diff, -jnp.inf))
        a = jnp.einsum('bhtk,bhsk,bhtsk->bhts', qi, ki, decay)
        o = o_inter + jnp.einsum('bhts,bhsv->bhtv', a, vi)
        b_last = b[:, :, -1:, :]
        S_new = jnp.exp(b_last[:, :, 0, :])[..., None] * S + jnp.einsum('bhsk,bhsv->bhkv', ki * jnp.exp(b_last - b), vi)
        return S_new, o

    S_fin, oc = lax.scan(step, s0, (to_chunks(q), to_chunks(k), to_chunks(v), to_chunks(g)))
    return oc.transpose(1, 0, 3, 2, 4).reshape(B_, L, H, dv), S_fin


def gla_prepare(q, k, v, a_f, a_b, wa_f, ba_f, wa_b, ba_b):
    B_, L, _ = q.shape
    f32 = jnp.float32

    def hd(t, d):
        return t.astype(f32).reshape(B_, L, GLA_HEADS, d)

    def log_decay(a, w, b):
        return hd(jax.nn.log_sigmoid((a @ w + b).astype(f32)) / GLA_GATE_NORM, GLA_DK)

    return (hd(q, GLA_DK) * GLA_DK ** -0.5, hd(k, GLA_DK), hd(v, GLA_DV),
            log_decay(a_f, wa_f, ba_f), log_decay(a_b, wa_b, ba_b))


def gla_bidirectional(con, lat):
    qc, kc, vc, gfc, gbc = con
    qx, kx, vx, gfx, gbx = lat
    s0 = jnp.zeros((qc.shape[0], GLA_HEADS, GLA_DK, GLA_DV), jnp.float32)
    rev = lambda t: t[:, ::-1]
    oc_f, sc_f = gla_chunk_scan(qc, kc, vc, gfc, s0)
    ox_f, _ = gla_chunk_scan(qx, kx, vx, gfx, sc_f)
    oc_b, sc_b = gla_chunk_scan(rev(qc), rev(kc), rev(vc), rev(gbc), s0)
    ox_b, _ = gla_chunk_scan(rev(qx), rev(kx), rev(vx), rev(gbx), sc_b)
    return oc_f + rev(oc_b), ox_f + rev(ox_b)


def gla_output(o, g_out, onorm_g):
    B_, L = o.shape[:2]
    on = rms_norm(o, onorm_g).reshape(B_, L, GLA_HEADS * GLA_DV).astype(g_out.dtype)
    return on * jax.nn.silu(g_out)


def spatial_gating(u, v, vnorm_g, ws, bs):
    B_, L, _ = v.shape
    n = L // SG_CHUNK
    u = jax.nn.gelu(u, approximate=False)
    vn = rms_norm(jax.nn.gelu(v, approximate=False).reshape(B_, L, SG_GROUPS, SG_DIM), vnorm_g)
    vc = vn.reshape(B_, n, SG_CHUNK, SG_GROUPS, SG_DIM)
    mixed = jnp.einsum('gts,bnsgc->bntgc', ws, vc) + bs.T[:, :, None]
    return u * mixed.reshape(B_, L, SG_GROUPS * SG_DIM)


def fourier_mix(h):
    B_, L, _ = h.shape
    hg = h.reshape(B_, L, FT_GROUPS, FT_DIM).astype(jnp.float32)
    out = jnp.fft.fft2(hg, axes=(1, 3), norm='ortho').real
    return out.astype(h.dtype).reshape(B_, L, FT_GROUPS * FT_DIM)


def mla_queries(qa, qa_g, wuq, qn_g, rope):
    B_, L, _ = qa.shape
    q = (rms_norm(qa, qa_g) @ wuq).reshape(B_, L, MLA_HEADS, MLA_NOPE + MLA_ROPE)
    q = rms_norm(q, qn_g)
    return q if rope is None else rope_tail(q, rope)


def mla_keys_values(kva, kpe, kva_g, wukv, kn_g, rope):
    B_, L, _ = kva.shape
    kv = (rms_norm(kva, kva_g) @ wukv).reshape(B_, L, MLA_HEADS, MLA_NOPE + MLA_V)
    k_pe = jnp.broadcast_to(kpe[:, :, None, :], (B_, L, MLA_HEADS, MLA_ROPE))
    k = rms_norm(jnp.concatenate([kv[..., :MLA_NOPE], k_pe], axis=-1), kn_g)
    k = k if rope is None else rope_tail(k, rope)
    return k, kv[..., MLA_NOPE:]


def block_attention(q, k, v):
    B_, Lq, H, dq = q.shape
    dv = v.shape[-1]
    nb = Lq // ATTN_BLOCK
    qb = q.reshape(B_, nb, ATTN_BLOCK, H, dq).transpose(1, 0, 2, 3, 4)
    scale = dq ** -0.5

    def one_block(qi):
        s = jnp.einsum('bqhd,bkhd->bhqk', qi, k, preferred_element_type=jnp.float32) * scale
        p = jax.nn.softmax(s, axis=-1).astype(v.dtype)
        return jnp.einsum('bhqk,bkhd->bqhd', p, v)

    ob = lax.map(one_block, qb)
    return ob.transpose(1, 0, 2, 3, 4).reshape(B_, Lq, H * dv)


def even_mixer(zx, zc, w_in, wa_f, ba_f, wa_b, ba_b, onorm_g, vnorm_g, ws, bs, need_ctx):
    qx, kx, vx, gx, afx, abx, ux, svx = split_cols(zx @ w_in, EV_SIZES)
    qc, kc, vc, gc, afc, abc, uc, svc = split_cols(zc @ w_in, EV_SIZES)
    lat = gla_prepare(qx, kx, vx, afx, abx, wa_f, ba_f, wa_b, ba_b)
    con = gla_prepare(qc, kc, vc, afc, abc, wa_f, ba_f, wa_b, ba_b)
    o_c, o_x = gla_bidirectional(con, lat)
    mx = jnp.concatenate([gla_output(o_x, gx, onorm_g), spatial_gating(ux, svx, vnorm_g, ws, bs)], axis=-1)
    mc = None
    if need_ctx:
        mc = jnp.concatenate([gla_output(o_c, gc, onorm_g), spatial_gating(uc, svc, vnorm_g, ws, bs)], axis=-1)
    return mx, mc


def odd_mixer(zx, zc, w_in, qa_g, wuq, kva_g, wukv, qn_g, kn_g, rope, need_ctx):
    ftx, qax, kvax, kpex = split_cols(zx @ w_in, OD_SIZES)
    qx = mla_queries(qax, qa_g, wuq, qn_g, rope)
    kx, vx = mla_keys_values(kvax, kpex, kva_g, wukv, kn_g, rope)
    if need_ctx:
        ftc, qac, kvac, kpec = split_cols(zc @ w_in, OD_SIZES)
    else:
        kvac, kpec = split_cols(zc @ w_in[:, OD_KV_COL0:], OD_SIZES[2:])
    kc, vc = mla_keys_values(kvac, kpec, kva_g, wukv, kn_g, None)
    att_x = block_attention(qx, jnp.concatenate([kc, kx], axis=1), jnp.concatenate([vc, vx], axis=1))
    mx = jnp.concatenate([fourier_mix(ftx), att_x], axis=-1)
    mc = None
    if need_ctx:
        qc = mla_queries(qac, qa_g, wuq, qn_g, None)
        mc = jnp.concatenate([fourier_mix(ftc), block_attention(qc, kc, vc)], axis=-1)
    return mx, mc


def setup_inputs(seed: int = 0) -> dict:
    key = jax.random.key(seed)
    keys = jax.random.split(key, 32)
    counter = iter(range(32))
    f32 = jnp.float32

    def nrm(shape, s):
        return jax.random.normal(keys[next(counter)], shape, f32) * s

    def gain(shape):
        return 1.0 + nrm(shape, 0.02)

    D = D_MODEL
    NE = (DEPTH + 1) // 2
    NO = DEPTH // 2
    return {
        "x": nrm((BATCH, SEQ, D), 1.0),
        "c": nrm((BATCH, D), 1.0),
        "ctx": nrm((BATCH, CTX_LEN, D), 1.0),
        "c_ctx": nrm((D,), 1.0),
        "ada_w": nrm((DEPTH, D, 6 * D), 0.5 * D ** -0.5),
        "ada_b": nrm((DEPTH, 6 * D), 0.02),
        "norm_mix_g": gain((DEPTH, D)),
        "norm_ffn_g": gain((DEPTH, D)),
        "w_mix_out": nrm((DEPTH, MIX_W, D), MIX_W ** -0.5),
        "ffn_w_in": nrm((DEPTH, D, 2 * FFN_HIDDEN), D ** -0.5),
        "ffn_w_out": nrm((DEPTH, FFN_HIDDEN, D), FFN_HIDDEN ** -0.5),
        "ev_w_in": nrm((NE, D, EV_IN_W), D ** -0.5),
        "gla_wa_f": nrm((NE, GLA_GATE_RANK, GLA_HEADS * GLA_DK), GLA_GATE_RANK ** -0.5),
        "gla_ba_f": nrm((NE, GLA_HEADS * GLA_DK), 0.1),
        "gla_wa_b": nrm((NE, GLA_GATE_RANK, GLA_HEADS * GLA_DK), GLA_GATE_RANK ** -0.5),
        "gla_ba_b": nrm((NE, GLA_HEADS * GLA_DK), 0.1),
        "gla_onorm_g": gain((NE, GLA_DV)),
        "sg_vnorm_g": gain((NE, SG_GROUPS, SG_DIM)),
        "sg_ws": nrm((NE, SG_GROUPS, SG_CHUNK, SG_CHUNK), SG_CHUNK ** -0.5),
        "sg_bs": gain((NE, SG_GROUPS, SG_CHUNK)),
        "od_w_in": nrm((NO, D, OD_IN_W), D ** -0.5),
        "mla_qa_g": gain((NO, MLA_Q_RANK)),
        "mla_wuq": nrm((NO, MLA_Q_RANK, MLA_HEADS * (MLA_NOPE + MLA_ROPE)), MLA_Q_RANK ** -0.5),
        "mla_kva_g": gain((NO, MLA_KV_RANK)),
        "mla_wukv": nrm((NO, MLA_KV_RANK, MLA_HEADS * (MLA_NOPE + MLA_V)), MLA_KV_RANK ** -0.5),
        "mla_qn_g": gain((NO, MLA_NOPE + MLA_ROPE)),
        "mla_kn_g": gain((NO, MLA_NOPE + MLA_ROPE)),
    }


def reference(x, c, ctx, c_ctx, ada_w, ada_b, norm_mix_g, norm_ffn_g, w_mix_out, ffn_w_in, ffn_w_out,
              ev_w_in, gla_wa_f, gla_ba_f, gla_wa_b, gla_ba_b, gla_onorm_g, sg_vnorm_g, sg_ws, sg_bs,
              od_w_in, mla_qa_g, mla_wuq, mla_kva_g, mla_wukv, mla_qn_g, mla_kn_g):
    rope = axial_rope(x.shape[1])
    silu_c = jax.nn.silu(c)
    silu_cc = jax.nn.silu(c_ctx)[None, :]
    h = ctx
    for l in range(DEPTH):
        need_ctx = l < DEPTH - 1
        sm_x, cm_x, gm_x, sf_x, cf_x, gf_x = split_mod(silu_c @ ada_w[l] + ada_b[l])
        sm_c, cm_c, gm_c, sf_c, cf_c, gf_c = split_mod(silu_cc @ ada_w[l] + ada_b[l])
        zx = modulate(rms_norm(x, norm_mix_g[l]), sm_x, cm_x)
        zc = modulate(rms_norm(h, norm_mix_g[l]), sm_c, cm_c)
        i = l // 2
        if l % 2 == 0:
            mx, mc = even_mixer(zx, zc, ev_w_in[i], gla_wa_f[i], gla_ba_f[i], gla_wa_b[i], gla_ba_b[i],
                                gla_onorm_g[i], sg_vnorm_g[i], sg_ws[i], sg_bs[i], need_ctx)
        else:
            mx, mc = odd_mixer(zx, zc, od_w_in[i], mla_qa_g[i], mla_wuq[i], mla_kva_g[i], mla_wukv[i],
                               mla_qn_g[i], mla_kn_g[i], rope, need_ctx)
        x = x + gm_x * (mx @ w_mix_out[l])
        x = x + gf_x * swiglu(modulate(rms_norm(x, norm_ffn_g[l]), sf_x, cf_x), ffn_w_in[l], ffn_w_out[l])
        if need_ctx:
            h = h + gm_c * (mc @ w_mix_out[l])
            h = h + gf_c * swiglu(modulate(rms_norm(h, norm_ffn_g[l]), sf_c, cf_c), ffn_w_in[l], ffn_w_out[l])
    return x
```

```cpp
#include <hip/hip_runtime.h>
#include <hip/hip_cooperative_groups.h>
#include <cstdio>
#include <cstdint>
#include <cmath>
namespace cg = cooperative_groups;
namespace pg8 {
#define PG8_LAS __attribute__((address_space(3)))
typedef unsigned short bf16_t;
typedef short bf16x8 __attribute__((ext_vector_type(8)));
typedef float f32x4 __attribute__((ext_vector_type(4)));
typedef unsigned u32x4 __attribute__((ext_vector_type(4)));
constexpr int BM = 256, BK = 64, HALF = 128, HTB = HALF * BK * 2  , STAGE_BYTES = 8 * HTB, NXCD = 8, WGM = 8;

__host__ __device__ __forceinline__ int lds_byte(int r, int c) { const int st = (r >> 4) * 2 + (c >> 5), rr = r & 15, cc = c & 31, ob = rr * 64 + cc * 2; return st * 1024 + (ob ^ (((ob >> 9) & 1) << 5)); }
__host__ __device__ __forceinline__ void stage_rc(int b, int& R, int& C) { const int st = b / 1024, sb = b % 1024, swz = sb ^ (((sb >> 9) & 1) << 5); R = (st >> 1) * 16 + swz / 64; C = (st & 1) * 32 + (swz % 64) / 2; }
__host__ __device__ __forceinline__ int perm32(int rho) { const int n = rho >> 4, i = rho & 15; return 8 * (i >> 2) + 4 * n + (i & 3); }

struct Unit { int pm, pn, kb, nt, ks; };
struct Gemm { const bf16_t* A; const bf16_t* Bt; int M, N, K; };

struct StaticOrder {
    int nM, nN, nwg, G, c;
    __host__ __device__ __forceinline__ void init(int M, int N, int G_, int c_) { nM = M / BM; nN = N / BM; nwg = nM * nN; G = G_; c = c_; }
    __host__ __device__ __forceinline__ bool next(int i, Unit& u) const {
        const long L = (long)i * G + c; if (L >= nwg) return false;
        int wgid = (int)L; { const int q = nwg / NXCD, r = nwg % NXCD, xcd = wgid % NXCD, off = wgid / NXCD; wgid = (xcd < r ? xcd * (q + 1) : r * (q + 1) + (xcd - r) * q) + off; }
        const int nig = WGM * nN, gid = wgid / nig, fm = gid * WGM, gsz = (nM - fm) < WGM ? (nM - fm) : WGM;
        u.pm = fm + ((wgid % nig) % gsz); u.pn = (wgid % nig) / gsz; u.kb = 0; u.nt = 0; u.ks = 0; return true;
    }
    __device__ __forceinline__ void a_ready(const Unit&) const {}
    __device__ __forceinline__ void done(const Unit&) const {}
};

__device__ __forceinline__ unsigned cvt_pk_bf16(float lo, float hi) { unsigned r; asm volatile("v_cvt_pk_bf16_f32 %0, %1, %2" : "=v"(r) : "v"(lo), "v"(hi)); return r; }
typedef float f32x2 __attribute__((ext_vector_type(2)));

struct TailOrder {
    StaticOrder so; int G, c, pairs, nw, ntail;
    __host__ __device__ __forceinline__ void init(int K, int G_, int c_, int ntail_) { so.init(16384, 1024, G_, c_); G = G_; c = c_; pairs = K / 128; nw = c_ < 256 ? (256 - c_ + G_ - 1) / G_ : 0; ntail = ntail_; }
    __host__ __device__ __forceinline__ bool next(int i, Unit& u) const {
        int pm = 0, pn = 0, kb = 0, nt = 0, ks = 0; bool ok;
        if (i < nw) {
            const int L0 = i * G + c; ok = L0 < 256; int wgid = L0 & 255; { const int xcd = wgid % NXCD, off = wgid / NXCD; wgid = xcd * 32 + off; }
            const int nig = WGM * 4, gid = wgid / nig, fm = gid * WGM; pm = fm + ((wgid % nig) % WGM); pn = (wgid % nig) / WGM;
        } else {
            const int j = (i - nw) * G + c; ok = j < ntail; const int tu = (j & 255) >> 3, s = j & 7, base = pairs >> 3, rem = pairs & 7;
            pm = 64 + (tu >> 2); pn = tu & 3; ks = s; nt = 2 * (base + (s < rem ? 1 : 0)); kb = 128 * (s * base + (s < rem ? s : rem));
        }
        u.pm = pm; u.pn = pn; u.kb = kb; u.nt = nt; u.ks = ks; return ok;
    }
    __device__ __forceinline__ void a_ready(const Unit&) const {}
    __device__ __forceinline__ void done(const Unit&) const {}
};

struct LdsOrder {
    __attribute__((address_space(3))) int* p;
    template <class S> __device__ __forceinline__ void fill(const S& s, int tid) {
        if (tid == 0) { for (int i = 0; i < 9; ++i) { Unit u; u.pm = 0; u.pn = 0; u.kb = 0; u.nt = 0; u.ks = 0; const bool ok = s.next(i, u); p[i * 8 + 0] = ok ? u.pm : -1; p[i * 8 + 1] = u.pn; p[i * 8 + 2] = u.kb; p[i * 8 + 3] = u.nt; p[i * 8 + 4] = u.ks; if (!ok) break; } }
        __syncthreads();
    }
    __device__ __forceinline__ bool next(int i, Unit& u) const {
        const int pm = __builtin_amdgcn_readfirstlane(p[i * 8 + 0]); if (pm < 0) return false;
        u.pm = pm; u.pn = __builtin_amdgcn_readfirstlane(p[i * 8 + 1]); u.kb = __builtin_amdgcn_readfirstlane(p[i * 8 + 2]); u.nt = __builtin_amdgcn_readfirstlane(p[i * 8 + 3]); u.ks = __builtin_amdgcn_readfirstlane(p[i * 8 + 4]); return true;
    }
    __device__ __forceinline__ void a_ready(const Unit&) const {}
    __device__ __forceinline__ void done(const Unit&) const {}
};
template <class Epi, class Sched, bool ALIGN_EPI = false, bool SP2 = false>
__device__ __forceinline__ void gemm_phase(PG8_LAS unsigned char* lds, const Gemm g, const Sched& S, const Epi& E) {
    int tid = threadIdx.x; asm volatile("" : "+v"(tid));
    const int wid = __builtin_amdgcn_readfirstlane(tid >> 6), lane = tid & 63, wr = wid >> 2, wc = wid & 3, fr = lane & 15, fq = lane >> 4;
    const int K = g.K, nt = K / BK;
    unsigned voffA[2], voffB[2];
#pragma unroll
    for (int i = 0; i < 2; ++i) { int R, C; stage_rc(tid * 16 + i * 8192, R, C); const int Rb = Epi::PERM ? ((R & ~31) + perm32(R & 31)) : R;
        voffA[i] = (unsigned)(R * K + C) * 2u; voffB[i] = (unsigned)(Rb * K + C) * 2u; }
    const size_t kstep = (size_t)(BK * 2);
    const size_t hstep = (size_t)HALF * K * 2;
    const size_t tstep = 2 * hstep;
    const unsigned ldsw = (unsigned)wid * 1024u;
    const int aoff = lds_byte(wr * 64 + fr, fq * 8), boff = lds_byte(wc * 32 + fr, fq * 8);
#define PG8_SA(b, h) (((b) * 2 + (h)) * HTB)
#define PG8_SB(b, h) ((4 + (b) * 2 + (h)) * HTB)
#define PG8_STAGE(bufoff, gbase, voff) do { _Pragma("unroll") for (int _i = 0; _i < 2; ++_i) \
        __builtin_amdgcn_global_load_lds((const unsigned*)((const char*)(gbase) + (voff)[_i]), (PG8_LAS unsigned*)(lds + (bufoff) + ldsw + _i * 8192), 16, 0, 0); } while (0)
#define PG8_LDA(dst, b, h) do { _Pragma("unroll") for (int m = 0; m < 4; ++m) _Pragma("unroll") for (int k = 0; k < 2; ++k) dst[m][k] = *(const PG8_LAS bf16x8*)(lds + PG8_SA(b, h) + aoff + m * 2048 + k * 1024); } while (0)
#define PG8_LDB(dst, b, h) do { _Pragma("unroll") for (int n = 0; n < 2; ++n) _Pragma("unroll") for (int k = 0; k < 2; ++k) dst[n][k] = *(const PG8_LAS bf16x8*)(lds + PG8_SB(b, h) + boff + n * 2048 + k * 1024); } while (0)
#define PG8_MMA(ai, bj, At, Bt) do { __builtin_amdgcn_s_setprio(1); _Pragma("unroll") for (int m = 0; m < 4; ++m) _Pragma("unroll") for (int n = 0; n < 2; ++n) _Pragma("unroll") for (int k = 0; k < 2; ++k) \
        acc[ai][bj][m][n] = __builtin_amdgcn_mfma_f32_16x16x32_bf16(Bt[n][k], At[m][k], acc[ai][bj][m][n], 0, 0, 0); __builtin_amdgcn_s_setprio(0); } while (0)
#define PG8_WAIT_V(n) asm volatile("s_waitcnt vmcnt(" #n ")" ::: "memory")
#define PG8_WAIT_L(n) asm volatile("s_waitcnt lgkmcnt(" #n ")" ::: "memory")
#define PG8_BAR __builtin_amdgcn_s_barrier()
#define PG8_SCHED __builtin_amdgcn_sched_barrier(0)
    Unit cur, nxt; int ui = 0;
    if (!S.next(0, cur)) return;
    f32x4 acc[2][2][4][2];
#pragma unroll
    for (int a = 0; a < 2; ++a)
#pragma unroll
        for (int b = 0; b < 2; ++b)
#pragma unroll
            for (int m = 0; m < 4; ++m)
#pragma unroll
                for (int n = 0; n < 2; ++n) acc[a][b][m][n] = (f32x4){0.f, 0.f, 0.f, 0.f};
    bf16x8 At[4][2], B0[2][2], B1[2][2];
    const char* cA = (const char*)g.A + (size_t)cur.pm * tstep + (size_t)cur.kb * 2; const char* cB = (const char*)g.Bt + (size_t)cur.pn * tstep + (size_t)cur.kb * 2;
    S.a_ready(cur);
    if constexpr (SP2) {
        PG8_STAGE(PG8_SB(0, 0), cB, voffB); PG8_STAGE(PG8_SB(0, 1), cB + hstep, voffB); PG8_STAGE(PG8_SA(0, 0), cA, voffA); PG8_STAGE(PG8_SA(0, 1), cA + hstep, voffA);
        if (wr == 1) PG8_BAR;
        PG8_WAIT_V(2); PG8_BAR;
        PG8_STAGE(PG8_SB(1, 0), cB + kstep, voffB); PG8_STAGE(PG8_SA(1, 0), cA + kstep, voffA); PG8_STAGE(PG8_SB(1, 1), cB + hstep + kstep, voffB);
        PG8_WAIT_V(6); PG8_BAR;
    } else {
        PG8_STAGE(PG8_SB(0, 0), cB, voffB); PG8_STAGE(PG8_SA(0, 0), cA, voffA); PG8_STAGE(PG8_SB(0, 1), cB + hstep, voffB); PG8_STAGE(PG8_SA(0, 1), cA + hstep, voffA);
        if (wr == 1) PG8_BAR;
        PG8_WAIT_V(4); PG8_BAR;
        PG8_STAGE(PG8_SB(1, 0), cB + kstep, voffB); PG8_STAGE(PG8_SA(1, 0), cA + kstep, voffA); PG8_STAGE(PG8_SB(1, 1), cB + hstep + kstep, voffB);
        PG8_WAIT_V(6); PG8_BAR;
    }
    for (;;) {
        const bool has_next = S.next(ui + 1, nxt);
        const char* nA = has_next ? (const char*)g.A + (size_t)nxt.pm * tstep + (size_t)nxt.kb * 2 : cA; const char* nB = has_next ? (const char*)g.Bt + (size_t)nxt.pn * tstep + (size_t)nxt.kb * 2 : cB;
        const int unt = cur.nt ? cur.nt : nt;
        for (int t = 0; t < unt; t += 2) {
            const bool last = (t == unt - 2);
            const char* a1 = cA + (size_t)(t + 1) * kstep;
            const char* a2 = last ? nA : cA + (size_t)(t + 2) * kstep; const char* b2 = last ? nB : cB + (size_t)(t + 2) * kstep;
            const char* a3 = a2 + kstep; const char* b3 = b2 + kstep;
            if (last && has_next) S.a_ready(nxt);
            if constexpr (SP2) {
            PG8_LDB(B0, 0, 0); PG8_LDB(B1, 0, 1); PG8_SCHED; PG8_LDA(At, 0, 0); PG8_STAGE(PG8_SA(1, 1), a1 + hstep, voffA);
            PG8_WAIT_V(8); PG8_WAIT_L(0); PG8_BAR; PG8_MMA(0, 0, At, B0); PG8_MMA(0, 1, At, B1); PG8_BAR; PG8_SCHED;
            PG8_LDA(At, 0, 1); PG8_STAGE(PG8_SB(0, 0), b2, voffB); PG8_STAGE(PG8_SB(0, 1), b2 + hstep, voffB); PG8_STAGE(PG8_SA(0, 0), a2, voffA);
            PG8_WAIT_V(8); PG8_WAIT_L(0); PG8_BAR; PG8_MMA(1, 0, At, B0); PG8_MMA(1, 1, At, B1); PG8_BAR; PG8_SCHED;
            PG8_LDB(B0, 1, 0); PG8_LDB(B1, 1, 1); PG8_SCHED; PG8_LDA(At, 1, 0); PG8_STAGE(PG8_SA(0, 1), a2 + hstep, voffA);
            PG8_WAIT_V(8); PG8_WAIT_L(0); PG8_BAR; PG8_MMA(0, 0, At, B0); PG8_MMA(0, 1, At, B1); PG8_BAR; PG8_SCHED;
            PG8_LDA(At, 1, 1); PG8_STAGE(PG8_SB(1, 0), b3, voffB); PG8_STAGE(PG8_SB(1, 1), b3 + hstep, voffB); PG8_STAGE(PG8_SA(1, 0), a3, voffA);
            PG8_WAIT_V(8); PG8_WAIT_L(0); PG8_BAR; PG8_MMA(1, 0, At, B0); PG8_MMA(1, 1, At, B1); PG8_BAR; PG8_SCHED;
            } else {
            PG8_LDB(B0, 0, 0); PG8_SCHED; PG8_LDA(At, 0, 0); PG8_STAGE(PG8_SA(1, 1), a1 + hstep, voffA);
            PG8_WAIT_L(8); PG8_BAR; PG8_WAIT_L(0); PG8_MMA(0, 0, At, B0); PG8_BAR; PG8_SCHED;
            PG8_LDB(B1, 0, 1); PG8_STAGE(PG8_SB(0, 0), b2, voffB);
            PG8_BAR; PG8_WAIT_L(0); PG8_MMA(0, 1, At, B1); PG8_BAR;
            PG8_LDA(At, 0, 1); PG8_STAGE(PG8_SA(0, 0), a2, voffA);
            PG8_BAR; PG8_WAIT_L(0); PG8_MMA(1, 0, At, B0); PG8_BAR; PG8_SCHED;
            PG8_STAGE(PG8_SB(0, 1), b2 + hstep, voffB);
            PG8_WAIT_V(6); PG8_BAR; PG8_MMA(1, 1, At, B1); PG8_BAR;
            PG8_LDB(B0, 1, 0); PG8_SCHED; PG8_LDA(At, 1, 0); PG8_STAGE(PG8_SA(0, 1), a2 + hstep, voffA);
            PG8_WAIT_L(8); PG8_BAR; PG8_WAIT_L(0); PG8_MMA(0, 0, At, B0); PG8_BAR; PG8_SCHED;
            PG8_LDB(B1, 1, 1); PG8_STAGE(PG8_SB(1, 0), b3, voffB);
            PG8_BAR; PG8_WAIT_L(0); PG8_MMA(0, 1, At, B1); PG8_BAR;
            PG8_LDA(At, 1, 1); PG8_STAGE(PG8_SA(1, 0), a3, voffA);
            PG8_BAR; PG8_WAIT_L(0); PG8_MMA(1, 0, At, B0); PG8_BAR; PG8_SCHED;
            PG8_STAGE(PG8_SB(1, 1), b3 + hstep, voffB);
            PG8_WAIT_V(6); PG8_BAR; PG8_MMA(1, 1, At, B1); PG8_BAR;
            }
        }
        if constexpr (ALIGN_EPI) { if (wr == 0) PG8_BAR; }
        if constexpr (!Epi::AFTER_DRAIN) { E(acc, cur, wr, wc, fr, fq); S.done(cur); }
        if (!has_next) break;
#pragma unroll
        for (int a = 0; a < 2; ++a)
#pragma unroll
            for (int b = 0; b < 2; ++b)
#pragma unroll
                for (int m = 0; m < 4; ++m)
#pragma unroll
                    for (int n = 0; n < 2; ++n) acc[a][b][m][n] = (f32x4){0.f, 0.f, 0.f, 0.f};
        cur = nxt; cA = nA; cB = nB; ++ui;
        if constexpr (ALIGN_EPI) { if (wr == 1) PG8_BAR; }
    }
    PG8_WAIT_V(0);
    if constexpr (!ALIGN_EPI) { if (wr == 0) PG8_BAR; }
    PG8_BAR;
    if constexpr (Epi::AFTER_DRAIN) { E.fused(acc, cur, wr, wc, fr, fq, lds, wid, lane); S.done(cur); }
#undef PG8_SA
#undef PG8_SB
#undef PG8_STAGE
#undef PG8_LDA
#undef PG8_LDB
#undef PG8_MMA
#undef PG8_WAIT_V
#undef PG8_WAIT_L
#undef PG8_BAR
#undef PG8_SCHED
}
}

#define LAS __attribute__((address_space(3)))
typedef unsigned short bf16;
typedef short bf16x8 __attribute__((ext_vector_type(8)));
typedef short v4i16_t __attribute__((ext_vector_type(4)));
typedef float f32x4 __attribute__((ext_vector_type(4)));
typedef float f32x2 __attribute__((ext_vector_type(2)));
typedef unsigned u32x4 __attribute__((ext_vector_type(4)));
typedef unsigned u32x2 __attribute__((ext_vector_type(2)));

constexpr int NTX = 16384, NTC = 2048, NTOK = 18432, DM = 1024, FF = 2816;
constexpr int EVW = 2592, EVP = 2816, ODP = 1280;
constexpr float EPS = 1e-6f;
constexpr size_t MiB = 1u << 20;
constexpr size_t WS_MOD = 1 * MiB, WS_WEV = 2 * MiB, WS_WOD = 13 * MiB, WS_WUQ = 18 * MiB, WS_WUKV = 20 * MiB, WS_WMIX = 22 * MiB,
                 WS_WFI = 30 * MiB, WS_WFO = 74 * MiB, WS_SGW = 96 * MiB, WS_DFTC = 96 * MiB + 512 * 1024, WS_DFTX = 97 * MiB, WS_H = 113 * MiB,
                 WS_ZX = 121 * MiB, WS_R1 = 157 * MiB, WS_R2 = 256 * MiB, WS_END = 366 * MiB;
constexpr size_t R1_QA = 0, R1_KVA = 14 * MiB, R1_KPE = 23 * MiB, R1_FBX = 26 * MiB, R1_FBC = 42 * MiB, R1_YQ = 44 * MiB;
constexpr size_t R2_U = 0, R2_DD = 72 * MiB, R2_SB = 73 * MiB, R2_YKV = 0, R2_KK = 54 * MiB;
constexpr int LDS_BYTES = 131072 + 1024;

struct Args { const float* in[27]; float* out; unsigned char* ws; int ph_lo, ph_hi; };

__device__ __forceinline__ unsigned f2bf(float f) { unsigned u = __float_as_uint(f); return (u + 0x7fffu + ((u >> 16) & 1u)) >> 16; }
__device__ __forceinline__ unsigned pk2(float lo, float hi) { unsigned r; asm("v_cvt_pk_bf16_f32 %0, %1, %2" : "=v"(r) : "v"(lo), "v"(hi)); return r; }
__device__ __forceinline__ float bf2f(bf16 h) { return __uint_as_float((unsigned)h << 16); }
__device__ __forceinline__ float bflo(unsigned w) { return __uint_as_float(w << 16); }
__device__ __forceinline__ float bfhi(unsigned w) { return __uint_as_float(w & 0xffff0000u); }
__device__ __forceinline__ float wave_sum(float v) {
#pragma unroll
    for (int o = 1; o < 64; o <<= 1) v += __shfl_xor(v, o);
    return v;
}
__device__ __forceinline__ float silu_f(float x) { return x * __builtin_amdgcn_rcpf(1.f + __expf(-x)); }
__device__ __forceinline__ float gelu_f(float v) {
    const float t = __builtin_amdgcn_rcpf(fabsf(v) * 0.2316418882f + 1.0f);
    float q = t * 0.5307027145f + (-0.7265760135f); q = q * t + 0.7107068705f; q = q * t + (-0.142248368f); q = q * t + 0.127414796f; q = q * t;
    const float m = v * (q * __builtin_amdgcn_exp2f(v * v * (-0.72134752044f)));
    return v < 0.f ? m : v - m;
}
__device__ __forceinline__ float logsig_f(float y) { return fminf(y, 0.f) - __logf(1.f + __expf(-fabsf(y))); }
#define LDS_WAIT() asm volatile("s_waitcnt lgkmcnt(0)" ::: "memory")
__device__ __forceinline__ bf16x8 tr2(const LAS unsigned char* p1, const LAS unsigned char* p2) {
    v4i16_t lo = __builtin_amdgcn_ds_read_tr16_b64_v4i16((LAS v4i16_t*)p1);
    v4i16_t hi = __builtin_amdgcn_ds_read_tr16_b64_v4i16((LAS v4i16_t*)p2);
    return (bf16x8){lo[0], lo[1], lo[2], lo[3], hi[0], hi[1], hi[2], hi[3]};
}
#define MFMA16(a, b, c) __builtin_amdgcn_mfma_f32_16x16x32_bf16((a), (b), (c), 0, 0, 0)

struct EpiStore {
    static constexpr bool PERM = true, AFTER_DRAIN = false;
    bf16* O; int ldc; int ncols;
    __device__ __forceinline__ void operator()(const pg8::f32x4 (&acc)[2][2][4][2], const pg8::Unit& u, int wr, int wc, int fr, int fq) const {
        const int row0 = u.pm * 256 + wr * 64 + fr, col0 = u.pn * 256 + wc * 32 + 8 * fq;
#pragma unroll
        for (int ai = 0; ai < 2; ++ai)
#pragma unroll
            for (int m = 0; m < 4; ++m) { bf16* rowp = O + (size_t)(row0 + ai * 128 + m * 16) * ldc;
#pragma unroll
                for (int bj = 0; bj < 2; ++bj) { const int col = col0 + bj * 128;
                    if (col < ncols) { const pg8::f32x4 v0 = acc[ai][bj][m][0], v1 = acc[ai][bj][m][1]; u32x4 w; w.x = pk2(v0[0], v0[1]); w.y = pk2(v0[2], v0[3]); w.z = pk2(v1[0], v1[1]); w.w = pk2(v1[2], v1[3]);
                        *(u32x4*)(rowp + col) = w; } } }
    }
};
struct EpiOddIn {
    static constexpr bool PERM = true, AFTER_DRAIN = false;
    bf16 *QA, *KVA, *KPE, *FBX, *FBC;
    __device__ __forceinline__ void operator()(const pg8::f32x4 (&acc)[2][2][4][2], const pg8::Unit& u, int wr, int wc, int fr, int fq) const {
        if (u.pn >= 2) {
            const int row0 = u.pm * 256 + wr * 64 + fr, col0 = (u.pn - 2) * 256 + wc * 32 + 8 * fq;
#pragma unroll
            for (int ai = 0; ai < 2; ++ai)
#pragma unroll
                for (int m = 0; m < 4; ++m) { const size_t row = (size_t)(row0 + ai * 128 + m * 16);
#pragma unroll
                    for (int bj = 0; bj < 2; ++bj) { const int col = col0 + bj * 128;
                        if (col < 704) { const pg8::f32x4 v0 = acc[ai][bj][m][0], v1 = acc[ai][bj][m][1]; u32x4 w; w.x = pk2(v0[0], v0[1]); w.y = pk2(v0[2], v0[3]); w.z = pk2(v1[0], v1[1]); w.w = pk2(v1[2], v1[3]);
                            bf16* dst = col < 384 ? QA + row * 384 + col : (col < 640 ? KVA + row * 256 + (col - 384) : KPE + row * 64 + (col - 640));
                            *(u32x4*)dst = w; } } }
        } else {
            bf16* base; int stride, t0;
            if (u.pm < 64) { base = FBX + (size_t)(u.pm >> 3) * 256 * 4096 + u.pn * 2048; stride = 4096; t0 = (u.pm & 7) * 256; }
            else { base = FBC + (size_t)(u.pm - 64) * 256 * 512 + u.pn * 256; stride = 512; t0 = 0; }
#pragma unroll
            for (int ai = 0; ai < 2; ++ai)
#pragma unroll
                for (int m = 0; m < 4; ++m) { const int t = t0 + ai * 128 + wr * 64 + m * 16 + fr;
#pragma unroll
                    for (int bj = 0; bj < 2; ++bj)
#pragma unroll
                        for (int n = 0; n < 2; ++n)
#pragma unroll
                            for (int e = 0; e < 4; ++e) { const int c = bj * 128 + wc * 32 + 8 * fq + 4 * n + e; base[(size_t)c * stride + t] = (bf16)f2bf(acc[ai][bj][m][n][e]); } }
        }
    }
};
struct EpiResid {
    static constexpr bool PERM = true, AFTER_DRAIN = false;
    const float* xb; const float* hb; float* xo; float* ho; const float* gate; bf16* T;
    __device__ __forceinline__ void operator()(const pg8::f32x4 (&acc)[2][2][4][2], const pg8::Unit& u, int wr, int wc, int fr, int fq) const {
        const bool isx = u.pm < 64; const int mr = isx ? (u.pm >> 3) : 8;
        const int rbase = isx ? u.pm * 256 : (u.pm - 64) * 256;
        const float* gp = gate + (size_t)mr * 6144; const int col0 = u.pn * 256 + wc * 32 + 8 * fq;
        if (!isx) { bf16* tp = T + (size_t)u.ks * 2048 * DM;
#pragma unroll
            for (int bj = 0; bj < 2; ++bj) { const int c = col0 + bj * 128; const pg8::f32x4 g0 = *(const pg8::f32x4*)(gp + c), g1 = *(const pg8::f32x4*)(gp + c + 4);
#pragma unroll
                for (int ai = 0; ai < 2; ++ai)
#pragma unroll
                    for (int m = 0; m < 4; ++m) { const size_t off = (size_t)(rbase + ai * 128 + wr * 64 + m * 16 + fr) * DM + c; const pg8::f32x4 v0 = g0 * acc[ai][bj][m][0], v1 = g1 * acc[ai][bj][m][1]; u32x4 w; w.x = pk2(v0[0], v0[1]); w.y = pk2(v0[2], v0[3]); w.z = pk2(v1[0], v1[1]); w.w = pk2(v1[2], v1[3]); *(u32x4*)(tp + off) = w; } }
            return; }
#pragma unroll
        for (int bj = 0; bj < 2; ++bj) { const int c = col0 + bj * 128; const pg8::f32x4 g0 = *(const pg8::f32x4*)(gp + c), g1 = *(const pg8::f32x4*)(gp + c + 4);
#pragma unroll
            for (int ai = 0; ai < 2; ++ai)
#pragma unroll
                for (int m = 0; m < 4; ++m) { const size_t off = (size_t)(rbase + ai * 128 + wr * 64 + m * 16 + fr) * DM + c;
                    const pg8::f32x4 b0 = *(const pg8::f32x4*)(xb + off), b1 = *(const pg8::f32x4*)(xb + off + 4);
                    *(pg8::f32x4*)(xo + off) = b0 + g0 * acc[ai][bj][m][0]; *(pg8::f32x4*)(xo + off + 4) = b1 + g1 * acc[ai][bj][m][1]; } }
    }
};
struct EpiSwiglu {
    static constexpr bool PERM = true, AFTER_DRAIN = false;
    bf16* ACT;
    __device__ __forceinline__ void operator()(const pg8::f32x4 (&acc)[2][2][4][2], const pg8::Unit& u, int wr, int wc, int fr, int fq) const {
        const int row0 = u.pm * 256 + wr * 64 + fr, col = u.pn * 128 + wc * 32 + 8 * fq;
#pragma unroll
        for (int ai = 0; ai < 2; ++ai)
#pragma unroll
            for (int m = 0; m < 4; ++m) { float o[8];
#pragma unroll
                for (int n = 0; n < 2; ++n)
#pragma unroll
                    for (int e = 0; e < 4; ++e) { const float g = acc[ai][0][m][n][e], up = acc[ai][1][m][n][e]; o[4 * n + e] = silu_f(g) * up; }
                u32x4 w; w.x = pk2(o[0], o[1]); w.y = pk2(o[2], o[3]); w.z = pk2(o[4], o[5]); w.w = pk2(o[6], o[7]);
                *(u32x4*)(ACT + (size_t)(row0 + ai * 128 + m * 16) * FF + col) = w; }
    }
};
struct EpiFourier {
    static constexpr bool PERM = true, AFTER_DRAIN = false;
    bf16* MX; int rowbase, rpb; float scale;
    __device__ __forceinline__ void operator()(const pg8::f32x4 (&acc)[2][2][4][2], const pg8::Unit& u, int wr, int wc, int fr, int fq) const {
        const int k0 = u.pm * 256 + wr * 64 + fr, col0 = wc * 32 + 8 * fq;
#pragma unroll
        for (int ai = 0; ai < 2; ++ai)
#pragma unroll
            for (int m = 0; m < 4; ++m) { bf16* rowp = MX + (size_t)(rowbase + u.pn * rpb + k0 + ai * 128 + m * 16) * DM + col0;
#pragma unroll
                for (int bj = 0; bj < 2; ++bj) { const pg8::f32x4 v0 = acc[ai][bj][m][0] * scale, v1 = acc[ai][bj][m][1] * scale; u32x4 w; w.x = pk2(v0[0], v0[1]); w.y = pk2(v0[2], v0[3]); w.z = pk2(v1[0], v1[1]); w.w = pk2(v1[2], v1[3]);
                    *(u32x4*)(rowp + bj * 128) = w; } }
    }
};

#define XB_TMO      128
#define XB_XCNT(j)  (256  + 64 * (j))
#define XB_XSUB(j)  (1280 + 64 * (j))
#define XB_XGEN(j)  (2304 + 64 * (j))
#define XB_TOP      3328
#define XB_TOPGEN   3392
#define XCD_BAR_WORDS 3456
#define XB_SPIN_CAP (1u << 18)

__device__ __forceinline__ unsigned xb_ld(unsigned* p)              { return __hip_atomic_load(p, __ATOMIC_RELAXED, __HIP_MEMORY_SCOPE_AGENT); }
__device__ __forceinline__ unsigned xb_add(unsigned* p, unsigned v) { return __hip_atomic_fetch_add(p, v, __ATOMIC_RELAXED, __HIP_MEMORY_SCOPE_AGENT); }
__device__ __forceinline__ unsigned xb_xcc_id() { return (unsigned)__builtin_amdgcn_s_getreg((3 << 11) | 20) & 0xFu; }
#define XB_SPIN(cond, bar) do { unsigned _sp = 0; while (cond) { __builtin_amdgcn_s_sleep(1); \
    if ((++_sp & 255u) == 0u) { if (xb_ld(&(bar)[XB_TMO])) break; if (_sp > XB_SPIN_CAP) { atomicAdd(&(bar)[XB_TMO], 1u); break; } } } } while (0)

struct XcdBarrier {
    unsigned* bar; unsigned x;
    volatile LAS unsigned* st;
};

__device__ __forceinline__ XcdBarrier xcd_barrier_post(unsigned* bar, volatile LAS unsigned* st) {
    XcdBarrier b; b.bar = bar; b.x = xb_xcc_id(); b.st = st;
    if (threadIdx.x == 0) (void)xb_add(&bar[XB_XCNT(b.x)], 1u);
    return b;
}
__device__ __forceinline__ void xcd_barrier_complete(unsigned* bar, unsigned x, unsigned& nloc, unsigned& nx) {
    const unsigned G = gridDim.x * gridDim.y * gridDim.z;
    unsigned sum, cnt, mine, sp = 0u;
    for (;;) {
        sum = 0u; cnt = 0u; mine = 0u;
#pragma unroll
        for (unsigned j = 0; j < 16; ++j) { const unsigned c = xb_ld(&bar[XB_XCNT(j)]); sum += c; cnt += (c > 0u) ? 1u : 0u; mine = (j == x) ? c : mine; }
        if (sum == G) break;
        __builtin_amdgcn_s_sleep(1);
        if ((++sp & 255u) == 0u) { if (xb_ld(&bar[XB_TMO])) break; if (sp > XB_SPIN_CAP) { atomicAdd(&bar[XB_TMO], 1u); break; } }
    }
    nloc = mine > 0u ? mine : 1u; nx = cnt > 0u ? cnt : 1u;
}

__device__ __forceinline__ void xcd_barrier(const XcdBarrier& b) {
    asm volatile("s_waitcnt vmcnt(0)" ::: "memory");
    __syncthreads();
    if (threadIdx.x == 0) {
        unsigned* bar = b.bar;
        __builtin_amdgcn_s_waitcnt(0);
        unsigned nloc = b.st[0], nx = b.st[1];
        if (nloc == 0u) { xcd_barrier_complete(bar, b.x, nloc, nx); b.st[0] = nloc; b.st[1] = nx; }
        const unsigned old = xb_add(&bar[XB_XSUB(b.x)], 1u);
        const unsigned gen = old / nloc;
        if (old + 1u == (gen + 1u) * nloc) {
            __builtin_amdgcn_fence(__ATOMIC_RELEASE, "agent");
            asm volatile("s_waitcnt vmcnt(0)" ::: "memory");
            const unsigned og = xb_add(&bar[XB_TOP], 1u);
            const unsigned tg = og / nx;
            if (og + 1u == (tg + 1u) * nx) xb_add(&bar[XB_TOPGEN], 1u);
            else XB_SPIN(xb_ld(&bar[XB_TOPGEN]) == tg, bar);
            __builtin_amdgcn_fence(__ATOMIC_ACQUIRE, "agent");
            xb_add(&bar[XB_XGEN(b.x)], 1u);
            asm volatile("s_waitcnt vmcnt(0)" ::: "memory");
        } else {
            XB_SPIN(xb_ld(&bar[XB_XGEN(b.x)]) == gen, bar);
            __builtin_amdgcn_fence(__ATOMIC_ACQUIRE, "agent");
            asm volatile("s_waitcnt vmcnt(0)" ::: "memory");
        }
    }
    __syncthreads();
}

__device__ __forceinline__ const float* ldptr(LAS unsigned char* L, int i) {
    const LAS unsigned* p = (const LAS unsigned*)(L + 131072) + 2 * i;
    const unsigned lo = __builtin_amdgcn_readfirstlane(p[0]), hi = __builtin_amdgcn_readfirstlane(p[1]);
    return (const float*)(((unsigned long long)hi << 32) | (unsigned long long)lo);
}
#define INP(i) ldptr(L, (i))
#define OUTP ((float*)ldptr(L, 27))
#define WSP ((unsigned char*)ldptr(L, 28))
__device__ __forceinline__ void tr_item(const float* W, int ldw, int K, int ncb, bf16* WT, int row_off, int mode, const float* gk, LAS float* scr, int item, int lane) {
    const int kb = item / ncb, nb = item % ncb, k0 = 64 * kb, n0 = 32 * nb;
    { const int kq = lane >> 3, nq = lane & 7; f32x4 v[8];
#pragma unroll
      for (int i = 0; i < 8; ++i) v[i] = *(const f32x4*)(W + (size_t)(k0 + 8 * i + kq) * ldw + n0 + 4 * nq);
#pragma unroll
      for (int i = 0; i < 8; ++i) { const int kk = 8 * i + kq; const float gv = gk ? gk[k0 + kk] : 1.0f; LAS float* d = scr + kk * 33 + 4 * nq; d[0] = v[i].x * gv; d[1] = v[i].y * gv; d[2] = v[i].z * gv; d[3] = v[i].w * gv; } }
    LDS_WAIT();
    const int c = lane & 7;
#pragma unroll
    for (int j = 0; j < 4; ++j) { const int n = (lane >> 3) + 8 * j; const LAS float* s = scr + (8 * c) * 33 + n;
        u32x4 o; o.x = pk2(s[0 * 33], s[1 * 33]); o.y = pk2(s[2 * 33], s[3 * 33]); o.z = pk2(s[4 * 33], s[5 * 33]); o.w = pk2(s[6 * 33], s[7 * 33]);
        const int nn = n0 + n; int dr = nn;
        if (mode == 1) dr = nn < FF ? ((nn >> 7) * 256 + (nn & 127)) : ((((nn - FF) >> 7) * 256) + 128 + ((nn - FF) & 127));
        *(u32x4*)(WT + (size_t)(row_off + dr) * K + k0 + 8 * c) = o; }
    LDS_WAIT();
}

__device__ __forceinline__ void prologue(LAS unsigned char* L, int tid, int wave, int lane) {
    unsigned char* ws = WSP;
    LAS float* tab = (LAS float*)L;
    LAS float* sv = (LAS float*)(L + 8192);
    LAS float* red = (LAS float*)(L + 45056);
    const int G = gridDim.x, bid = blockIdx.x;
    const size_t gtid_all = (size_t)bid * 512 + tid, NT_all = (size_t)G * 512;
    LAS float* c64 = (LAS float*)(L + 81920); LAS float* s64 = c64 + 64;
    for (int i = tid; i < 2048; i += 512) tab[i] = cospif((float)i * (1.0f / 1024.0f));
    if (tid < 64) { c64[tid] = cospif((float)tid * (1.0f / 32.0f)); s64[tid] = -sinpif((float)tid * (1.0f / 32.0f)); }
    for (int i = tid; i < 9216; i += 512) { const int r = i >> 10, k = i & 1023; const float v = r < 8 ? INP(1)[r * 1024 + k] : INP(3)[k]; sv[i] = silu_f(v); }
    __syncthreads();
    float* MOD = (float*)(ws + WS_MOD);
    for (int it = bid; it < 192; it += G) {
        const int l = it / 48, col0 = (it % 48) * 128, col = col0 + 2 * lane;
        const float* wp = INP(4) + ((size_t)l * 1024 + wave * 128) * 6144 + col;
        float acc[9][2];
#pragma unroll
        for (int r = 0; r < 9; ++r) { acc[r][0] = 0.f; acc[r][1] = 0.f; }
#pragma unroll 8
        for (int k = 0; k < 128; ++k) { const f32x2 w = *(const f32x2*)(wp + (size_t)k * 6144);
#pragma unroll
            for (int r = 0; r < 9; ++r) { const float s = sv[r * 1024 + wave * 128 + k]; acc[r][0] += s * w.x; acc[r][1] += s * w.y; } }
#pragma unroll
        for (int r = 0; r < 9; ++r) { red[(wave * 9 + r) * 128 + 2 * lane] = acc[r][0]; red[(wave * 9 + r) * 128 + 2 * lane + 1] = acc[r][1]; }
        __syncthreads();
        for (int i = tid; i < 1152; i += 512) { const int r = i >> 7, cc = i & 127; float s = 0.f;
#pragma unroll
            for (int w = 0; w < 8; ++w) s += red[(w * 9 + r) * 128 + cc];
            MOD[((size_t)l * 9 + r) * 6144 + col0 + cc] = s + INP(5)[l * 6144 + col0 + cc]; }
        __syncthreads();
    }
    bf16* WOD = (bf16*)(ws + WS_WOD);
    const bool cvt_all = true; const size_t gtid = cvt_all ? gtid_all : (bid >= 192 ? (size_t)(bid - 192) * 512 + tid : (size_t)1 << 40); const size_t NT = cvt_all ? NT_all : (size_t)(G - 192) * 512;
    for (size_t idx = gtid; idx < (size_t)2 * 512 * 1024; idx += NT) {
        const int m = (int)idx & 63, kk = ((int)idx >> 6) & 1023, rest = (int)(idx >> 16), g = rest & 3, part = (rest >> 2) & 1, i = rest >> 3;
        const float* src = INP(20) + ((size_t)i * 1024 + kk) * 960 + g * 64; float acc = 0.f;
        const LAS float* tw64 = part ? s64 : c64;
        for (int c = 0; c < 64; ++c) { const int j = (m * c) & 63; acc += tw64[j] * src[c]; }
        WOD[((size_t)i * ODP + part * 256 + g * 64 + m) * 1024 + kk] = (bf16)f2bf(acc);
    }
    { bf16* SGW = (bf16*)(ws + WS_SGW); for (size_t idx = gtid; idx < 131072; idx += NT) SGW[idx] = (bf16)f2bf(INP(18)[idx]); }
    { bf16* DX = (bf16*)(ws + WS_DFTX);
      for (size_t idx = gtid; idx < (size_t)2048 * 512; idx += NT) { const int k = (int)(idx >> 9), t8 = ((int)idx & 511) * 8; float v[8];
#pragma unroll
          for (int e = 0; e < 8; ++e) { const int tp = t8 + e; v[e] = tp < 2048 ? tab[(k * tp) & 2047] : tab[(k * (tp - 2048) - 512) & 2047]; }
          u32x4 o; o.x = pk2(v[0], v[1]); o.y = pk2(v[2], v[3]); o.z = pk2(v[4], v[5]); o.w = pk2(v[6], v[7]); *(u32x4*)(DX + (size_t)k * 4096 + t8) = o; } }
    { bf16* DC = (bf16*)(ws + WS_DFTC);
      for (size_t idx = gtid; idx < (size_t)256 * 64; idx += NT) { const int k = (int)(idx >> 6), t8 = ((int)idx & 63) * 8; float v[8];
#pragma unroll
          for (int e = 0; e < 8; ++e) { const int tp = t8 + e; v[e] = tp < 256 ? tab[((k * tp) & 255) * 8] : tab[(((k * (tp - 256)) & 255) * 8 - 512) & 2047]; }
          u32x4 o; o.x = pk2(v[0], v[1]); o.y = pk2(v[2], v[3]); o.z = pk2(v[4], v[5]); o.w = pk2(v[6], v[7]); *(u32x4*)(DC + (size_t)k * 512 + t8) = o; } }
    { const u32x4 z = {0u, 0u, 0u, 0u};
      for (size_t idx = gtid; idx < (size_t)2 * 28672; idx += NT) { const int i = (int)(idx / 28672), r = (int)(idx % 28672); *(u32x4*)((bf16*)(ws + WS_WEV) + ((size_t)i * EVP + EVW) * 1024 + (size_t)r * 8) = z; }
      for (size_t idx = gtid; idx < (size_t)2 * 8192; idx += NT) { const int i = (int)(idx / 8192), r = (int)(idx % 8192); *(u32x4*)(WOD + ((size_t)i * ODP + 1216) * 1024 + (size_t)r * 8) = z; }
      for (size_t idx = gtid; idx < (size_t)2 * 6144; idx += NT) { const int i = (int)(idx / 6144), r = (int)(idx % 6144); *(u32x4*)((bf16*)(ws + WS_WUQ) + ((size_t)i * 1280 + 1152) * 384 + (size_t)r * 8) = z; } }
    __syncthreads();
    LAS float* scr = (LAS float*)(L + 45056 + wave * 8448);
    const int gw = bid * 8 + wave, NGW = G * 8;
    constexpr int I_EV = 16 * 81, I_OD = 16 * 22, I_UQ = 6 * 36, I_UKV = 4 * 48, I_MIX = 16 * 32, I_FI = 16 * 176, I_FO = 44 * 32;
    constexpr int NITEMS = 2 * (I_EV + I_OD + I_UQ + I_UKV) + 4 * (I_MIX + I_FI + I_FO);
    for (int it = gw; it < NITEMS; it += NGW) {
        int r = it;
        if (r < 4 * I_FI) { const int l = r / I_FI; tr_item(INP(9) + (size_t)l * 1024 * 5632, 5632, 1024, 176, (bf16*)(ws + WS_WFI) + (size_t)l * 5632 * 1024, 0, 1, nullptr, scr, r % I_FI, lane); continue; } r -= 4 * I_FI;
        if (r < 4 * I_FO) { const int l = r / I_FO; tr_item(INP(10) + (size_t)l * 2816 * 1024, 1024, 2816, 32, (bf16*)(ws + WS_WFO) + (size_t)l * 1024 * 2816, 0, 0, nullptr, scr, r % I_FO, lane); continue; } r -= 4 * I_FO;
        if (r < 4 * I_MIX) { const int l = r / I_MIX; tr_item(INP(8) + (size_t)l * 1024 * 1024, 1024, 1024, 32, (bf16*)(ws + WS_WMIX) + (size_t)l * 1024 * 1024, 0, 0, nullptr, scr, r % I_MIX, lane); continue; } r -= 4 * I_MIX;
        if (r < 2 * I_EV) { const int i = r / I_EV; tr_item(INP(11) + (size_t)i * 1024 * EVW, EVW, 1024, 81, (bf16*)(ws + WS_WEV) + (size_t)i * EVP * 1024, 0, 0, nullptr, scr, r % I_EV, lane); continue; } r -= 2 * I_EV;
        if (r < 2 * I_OD) { const int i = r / I_OD; tr_item(INP(20) + (size_t)i * 1024 * 960 + 256, 960, 1024, 22, WOD + (size_t)i * ODP * 1024, 512, 0, nullptr, scr, r % I_OD, lane); continue; } r -= 2 * I_OD;
        if (r < 2 * I_UQ) { const int i = r / I_UQ; tr_item(INP(22) + (size_t)i * 384 * 1152, 1152, 384, 36, (bf16*)(ws + WS_WUQ) + (size_t)i * 1280 * 384, 0, 0, INP(21) + i * 384, scr, r % I_UQ, lane); continue; } r -= 2 * I_UQ;
        { const int i = r / I_UKV; tr_item(INP(24) + (size_t)i * 256 * 1536, 1536, 256, 48, (bf16*)(ws + WS_WUKV) + (size_t)i * 1536 * 256, 0, 0, INP(23) + i * 256, scr, r % I_UKV, lane); }
    }
}

__device__ __forceinline__ void norm_phase(const float* xin, const float* hin, const float* gvec, const float* mod, int shift_idx, int scale_idx, bf16* Z, int ntok, int wave, int lane, const bf16* T, float* hout) {
    constexpr int NR = 4;
    const int gw = blockIdx.x * 8 + wave, NGW = gridDim.x * 8;
    f32x4 gg[4];
#pragma unroll
    for (int j = 0; j < 4; ++j) gg[j] = *(const f32x4*)(gvec + 4 * lane + 256 * j);
    for (int rb = gw; rb < ntok; rb += NR * NGW) {
        f32x4 v[NR][4];
#pragma unroll
        for (int q = 0; q < NR; ++q) { const int row = (rb + q * NGW < ntok) ? rb + q * NGW : rb; const float* src = row < NTX ? xin + (size_t)row * DM : hin + (size_t)(row - NTX) * DM;
#pragma unroll
            for (int j = 0; j < 4; ++j) v[q][j] = *(const f32x4*)(src + 4 * lane + 256 * j); }
        if (T && rb + (NR - 1) * NGW >= NTX) {
#pragma unroll
            for (int q = 0; q < NR; ++q) { const int row = rb + q * NGW; if (row >= NTX && row < ntok) {
#pragma unroll
                for (int sp = 0; sp < 8; ++sp)
#pragma unroll
                    for (int j = 0; j < 4; ++j) { const u32x2 w = *(const u32x2*)(T + ((size_t)sp * 2048 + (row - NTX)) * DM + 4 * lane + 256 * j); v[q][j] += (f32x4){bflo(w.x), bfhi(w.x), bflo(w.y), bfhi(w.y)}; }
#pragma unroll
                for (int j = 0; j < 4; ++j) *(f32x4*)(hout + (size_t)(row - NTX) * DM + 4 * lane + 256 * j) = v[q][j]; } }
        }
        float ss[NR];
#pragma unroll
        for (int q = 0; q < NR; ++q) { float s = 0.f;
#pragma unroll
            for (int j = 0; j < 4; ++j) s += (v[q][j].x * v[q][j].x + v[q][j].y * v[q][j].y) + (v[q][j].z * v[q][j].z + v[q][j].w * v[q][j].w);
            ss[q] = s; }
#pragma unroll
        for (int o = 1; o < 64; o <<= 1)
#pragma unroll
            for (int q = 0; q < NR; ++q) ss[q] += __shfl_xor(ss[q], o);
#pragma unroll
        for (int q = 0; q < NR; ++q) { const int row = rb + q * NGW; if (row < ntok) {
            const float rstd = rsqrtf(ss[q] * (1.f / DM) + EPS); const int mr = row < NTX ? (row >> 11) : 8; const float* mp = mod + (size_t)mr * 6144;
#pragma unroll
            for (int j = 0; j < 4; ++j) { const int c = 4 * lane + 256 * j; const f32x4 sc = *(const f32x4*)(mp + scale_idx * 1024 + c), sh = *(const f32x4*)(mp + shift_idx * 1024 + c);
                const f32x4 z = v[q][j] * rstd * gg[j] * (sc + 1.0f) + sh; u32x2 o; o.x = pk2(z.x, z.y); o.y = pk2(z.z, z.w); *(u32x2*)(Z + (size_t)row * DM + c) = o; } } }
    }
}

__device__ __forceinline__ int gla_tok0(int b, int c) { return c < 4 ? NTX + b * 256 + 64 * c : b * 2048 + 64 * (c - 4); }
__device__ __forceinline__ int gla_uidx(int dir, int b, int h, int c) { return ((dir * 8 + b) * 4 + h) * 36 + c; }
__device__ __forceinline__ void gla_gates(const LAS bf16* A32, const float (&wf)[16], const float (&wb)[16], float bf0, float bb0, LAS float* Gf, LAS float* Gb, LAS float* TOT, int tid) {
    const int k = tid & 63;
#pragma unroll 2
    for (int i = 0; i < 8; ++i) { const int p = (tid >> 6) + 8 * i; const LAS u32x4* ap = (const LAS u32x4*)(A32 + p * 32);
        const u32x4 a0 = ap[0], a1 = ap[1], b0 = ap[2], b1 = ap[3];
        float yf = bf0, yb = bb0;
#pragma unroll
        for (int w = 0; w < 4; ++w) { yf += bflo(a0[w]) * wf[2 * w] + bfhi(a0[w]) * wf[2 * w + 1]; yf += bflo(a1[w]) * wf[8 + 2 * w] + bfhi(a1[w]) * wf[9 + 2 * w];
                                      yb += bflo(b0[w]) * wb[2 * w] + bfhi(b0[w]) * wb[2 * w + 1]; yb += bflo(b1[w]) * wb[8 + 2 * w] + bfhi(b1[w]) * wb[9 + 2 * w]; }
        Gf[p * 64 + k] = logsig_f(yf) * 0.0625f; Gb[p * 64 + k] = logsig_f(yb) * 0.0625f; }
    __syncthreads();
    {
        const int dir = tid >> 8, seg = (tid >> 6) & 3; LAS float* arr = dir ? Gb : Gf; float a[16];
#pragma unroll
        for (int j = 0; j < 16; ++j) a[j] = arr[(16 * seg + j) * 64 + k];
        if (!dir) {
#pragma unroll
            for (int j = 1; j < 16; ++j) a[j] += a[j - 1];
            TOT[(dir * 4 + seg) * 64 + k] = a[15]; }
        else {
#pragma unroll
            for (int j = 14; j >= 0; --j) a[j] += a[j + 1];
            TOT[(dir * 4 + seg) * 64 + k] = a[0]; }
        __syncthreads();
        float off = 0.f;
#pragma unroll
        for (int s2 = 0; s2 < 4; ++s2) { const float t = TOT[(dir * 4 + s2) * 64 + k]; if (dir ? (s2 > seg) : (s2 < seg)) off += t; }
#pragma unroll
        for (int j = 0; j < 16; ++j) arr[(16 * seg + j) * 64 + k] = a[j] + off;
    }
    __syncthreads();
}
__device__ __forceinline__ void gla_passA(int unit, const bf16* P, const float* waf, const float* baf, const float* wab, const float* bab, bf16* U, float* DD, LAS unsigned char* L, int tid, int wave, int lane) {
    const int b = unit / 144, rem = unit % 144, h = rem / 36, c = rem % 36, tok0 = gla_tok0(b, c);
    LAS float* Gf = (LAS float*)L; LAS float* Gb = (LAS float*)(L + 16384);
    LAS bf16* KDf = (LAS bf16*)(L + 32768); LAS bf16* KDb = (LAS bf16*)(L + 32768 + 9216); LAS bf16* Vs = (LAS bf16*)(L + 32768 + 18432); LAS bf16* A32 = (LAS bf16*)(L + 32768 + 18432 + 18432);
    const int k = tid & 63, rpos = tid >> 3, rk8 = (tid & 7) * 8;
    u32x4 a32 = {0u, 0u, 0u, 0u}; if (tid < 256) a32 = *(const u32x4*)(P + (size_t)(tok0 + (tid >> 2)) * EVW + 1536 + (tid & 3) * 8);
    float wf[16], wb[16];
#pragma unroll
    for (int r = 0; r < 16; ++r) { wf[r] = waf[r * 256 + h * 64 + k]; wb[r] = wab[r * 256 + h * 64 + k]; }
    const float bf0 = baf[h * 64 + k], bb0 = bab[h * 64 + k];
    const u32x4 kraw = *(const u32x4*)(P + (size_t)(tok0 + rpos) * EVW + 256 + h * 64 + rk8);
    u32x4 vraw[2];
#pragma unroll
    for (int i = 0; i < 2; ++i) { const int q = tid + 512 * i; vraw[i] = *(const u32x4*)(P + (size_t)(tok0 + (q >> 4)) * EVW + 512 + h * 128 + (q & 15) * 8); }
    if (tid < 256) *(LAS u32x4*)(A32 + (tid >> 2) * 32 + (tid & 3) * 8) = a32;
#pragma unroll
    for (int i = 0; i < 2; ++i) { const int q = tid + 512 * i; *(LAS u32x4*)(Vs + (q >> 4) * 144 + (q & 15) * 8) = vraw[i]; }
    __syncthreads();
    gla_gates(A32, wf, wb, bf0, bb0, Gf, Gb, (LAS float*)((LAS unsigned char*)A32 + 4096), tid);
    {
        float kv[8];
#pragma unroll
        for (int w = 0; w < 4; ++w) { kv[2 * w] = bflo(kraw[w]); kv[2 * w + 1] = bfhi(kraw[w]); }
        u32x4 of, ob;
#pragma unroll
        for (int w = 0; w < 4; ++w) { const int k0 = rk8 + 2 * w;
            const float f0 = kv[2 * w] * __expf(Gf[63 * 64 + k0] - Gf[rpos * 64 + k0]), f1 = kv[2 * w + 1] * __expf(Gf[63 * 64 + k0 + 1] - Gf[rpos * 64 + k0 + 1]);
            const float g0 = kv[2 * w] * __expf(Gb[k0] - Gb[rpos * 64 + k0]), g1 = kv[2 * w + 1] * __expf(Gb[k0 + 1] - Gb[rpos * 64 + k0 + 1]);
            of[w] = pk2(f0, f1); ob[w] = pk2(g0, g1); }
        *(LAS u32x4*)(KDf + rpos * 72 + rk8) = of; *(LAS u32x4*)(KDb + rpos * 72 + rk8) = ob;
    }
    if (tid < 64) DD[(size_t)gla_uidx(0, b, h, c) * 64 + tid] = __expf(Gf[63 * 64 + tid]);
    else if (tid < 128) DD[(size_t)gla_uidx(1, b, h, c) * 64 + (tid - 64)] = __expf(Gb[tid - 64]);
    __syncthreads();
    const int g = lane >> 4, i15 = lane & 15, q4 = i15 >> 2, pp = i15 & 3, dv0 = 16 * wave;
    bf16x8 Af[2];
#pragma unroll
    for (int ks = 0; ks < 2; ++ks) { const LAS unsigned char* p1 = (const LAS unsigned char*)Vs + (32 * ks + 8 * g + q4) * 288 + (dv0 + 4 * pp) * 2; Af[ks] = tr2(p1, p1 + 4 * 288); }
#pragma unroll
    for (int dir = 0; dir < 2; ++dir) { const LAS unsigned char* KD = (const LAS unsigned char*)(dir ? KDb : KDf); bf16* up = U + (size_t)gla_uidx(dir, b, h, c) * 8192;
#pragma unroll
        for (int kt = 0; kt < 4; ++kt) { f32x4 acc = {0.f, 0.f, 0.f, 0.f};
#pragma unroll
            for (int ks = 0; ks < 2; ++ks) { const LAS unsigned char* p1 = KD + (32 * ks + 8 * g + q4) * 144 + (16 * kt + 4 * pp) * 2; const bf16x8 Bf = tr2(p1, p1 + 4 * 144); acc = MFMA16(Af[ks], Bf, acc); }
#pragma unroll
            for (int r = 0; r < 4; ++r) up[(dv0 + 4 * g + r) * 64 + 16 * kt + i15] = (bf16)f2bf(acc[r]); } }
    __syncthreads();
}
__device__ __forceinline__ void gla_passB(const bf16* U, const float* DD, bf16* SB, int tid) {
    const size_t NT = (size_t)gridDim.x * 512;
    for (size_t gid = (size_t)blockIdx.x * 512 + tid; gid < (size_t)64 * 2048; gid += NT) {
        const int e4 = (int)gid & 2047, seq = (int)(gid >> 11), dir = seq >> 5, bh = seq & 31, kq = (e4 * 4) & 63;
        f32x4 S = {0.f, 0.f, 0.f, 0.f};
        for (int s0 = 0; s0 < 36; s0 += 6) { f32x4 dd[6], uu[6]; size_t ui[6];
#pragma unroll
            for (int j = 0; j < 6; ++j) { const int step = s0 + j, c = dir ? (step < 4 ? 3 - step : 39 - step) : step; ui[j] = (size_t)(dir * 32 + bh) * 36 + c;
                dd[j] = *(const f32x4*)(DD + ui[j] * 64 + kq); { const u32x2 w = *(const u32x2*)(U + ui[j] * 8192 + (size_t)e4 * 4); uu[j] = (f32x4){bflo(w.x), bfhi(w.x), bflo(w.y), bfhi(w.y)}; } }
#pragma unroll
            for (int j = 0; j < 6; ++j) { u32x2 o; o.x = pk2(S.x, S.y); o.y = pk2(S.z, S.w); *(u32x2*)(SB + ui[j] * 8192 + (size_t)e4 * 4) = o; S = dd[j] * S + uu[j]; } }
    }
}
__device__ __forceinline__ void gla_passC(int unit, const bf16* P, const float* waf, const float* baf, const float* wab, const float* bab, const bf16* SB, const float* onorm, bf16* MX, LAS unsigned char* L, int tid, int wave, int lane) {
    const int b = unit / 144, rem = unit % 144, h = rem / 36, c = rem % 36, tok0 = gla_tok0(b, c);
    LAS float* Gf = (LAS float*)L; LAS float* Gb = (LAS float*)(L + 16384); LAS float* Os = (LAS float*)L;
    LAS bf16* QF = (LAS bf16*)(L + 32768); LAS bf16* KF = (LAS bf16*)(L + 32768 + 9216); LAS bf16* QB = (LAS bf16*)(L + 32768 + 2 * 9216); LAS bf16* KB = (LAS bf16*)(L + 32768 + 3 * 9216);
    LAS bf16* Vs = (LAS bf16*)(L + 69632); LAS bf16* AS = (LAS bf16*)(L + 88064); LAS bf16* A32 = (LAS bf16*)(L + 98304);
    const int k = tid & 63, rpos = tid >> 3, rk8 = (tid & 7) * 8;
    const int g = lane >> 4, i15 = lane & 15, q4 = i15 >> 2, pp = i15 & 3, t0 = 16 * (wave & 3), dvb = 64 * (wave >> 2);
    u32x4 a32 = {0u, 0u, 0u, 0u}; if (tid < 256) a32 = *(const u32x4*)(P + (size_t)(tok0 + (tid >> 2)) * EVW + 1536 + (tid & 3) * 8);
    float wf[16], wb[16];
#pragma unroll
    for (int r = 0; r < 16; ++r) { wf[r] = waf[r * 256 + h * 64 + k]; wb[r] = wab[r * 256 + h * 64 + k]; }
    const float bf0 = baf[h * 64 + k], bb0 = bab[h * 64 + k];
    const u32x4 qraw = *(const u32x4*)(P + (size_t)(tok0 + rpos) * EVW + h * 64 + rk8), kraw = *(const u32x4*)(P + (size_t)(tok0 + rpos) * EVW + 256 + h * 64 + rk8);
    u32x4 vraw[2];
#pragma unroll
    for (int i = 0; i < 2; ++i) { const int q = tid + 512 * i; vraw[i] = *(const u32x4*)(P + (size_t)(tok0 + (q >> 4)) * EVW + 512 + h * 128 + (q & 15) * 8); }
    const bf16* gp = P + (size_t)(tok0 + rpos) * EVW + 1024 + h * 128 + (tid & 7) * 16; const u32x4 g0 = *(const u32x4*)gp, g1 = *(const u32x4*)(gp + 8);
    const bf16* sbf = SB + (size_t)gla_uidx(0, b, h, c) * 8192; const bf16* sbb = SB + (size_t)gla_uidx(1, b, h, c) * 8192;
    bf16x8 Bsf[4][2], Bsb[4][2];
#pragma unroll
    for (int dt = 0; dt < 4; ++dt)
#pragma unroll
        for (int ks = 0; ks < 2; ++ks) { Bsf[dt][ks] = *(const bf16x8*)(sbf + (dvb + 16 * dt + i15) * 64 + 32 * ks + 8 * g); Bsb[dt][ks] = *(const bf16x8*)(sbb + (dvb + 16 * dt + i15) * 64 + 32 * ks + 8 * g); }
    if (tid < 256) *(LAS u32x4*)(A32 + (tid >> 2) * 32 + (tid & 3) * 8) = a32;
#pragma unroll
    for (int i = 0; i < 2; ++i) { const int q = tid + 512 * i; *(LAS u32x4*)(Vs + (q >> 4) * 144 + (q & 15) * 8) = vraw[i]; }
    __syncthreads();
    gla_gates(A32, wf, wb, bf0, bb0, Gf, Gb, (LAS float*)((LAS unsigned char*)A32 + 4096), tid);
    {
        u32x4 oqf, okf, oqb, okb;
#pragma unroll
        for (int w = 0; w < 4; ++w) { const int k0 = rk8 + 2 * w;
            const float q0 = bflo(qraw[w]) * 0.125f, q1 = bfhi(qraw[w]) * 0.125f, k0v = bflo(kraw[w]), k1v = bfhi(kraw[w]);
            const float gf0 = Gf[rpos * 64 + k0], gf1 = Gf[rpos * 64 + k0 + 1], gb0 = Gb[rpos * 64 + k0], gb1 = Gb[rpos * 64 + k0 + 1];
            oqf[w] = pk2(q0 * __expf(gf0), q1 * __expf(gf1)); okf[w] = pk2(k0v * __expf(-gf0), k1v * __expf(-gf1));
            oqb[w] = pk2(q0 * __expf(gb0), q1 * __expf(gb1)); okb[w] = pk2(k0v * __expf(-gb0), k1v * __expf(-gb1)); }
        *(LAS u32x4*)(QF + rpos * 72 + rk8) = oqf; *(LAS u32x4*)(KF + rpos * 72 + rk8) = okf; *(LAS u32x4*)(QB + rpos * 72 + rk8) = oqb; *(LAS u32x4*)(KB + rpos * 72 + rk8) = okb;
    }
    __syncthreads();
    {
        const int sb = 32 * (wave >> 2);
        bf16x8 Aqf[2], Aqb[2];
#pragma unroll
        for (int ks = 0; ks < 2; ++ks) { Aqf[ks] = *(const LAS bf16x8*)(QF + (t0 + i15) * 72 + 32 * ks + 8 * g); Aqb[ks] = *(const LAS bf16x8*)(QB + (t0 + i15) * 72 + 32 * ks + 8 * g); }
#pragma unroll
        for (int st = 0; st < 2; ++st) { const int s0 = sb + 16 * st; f32x4 af = {0.f, 0.f, 0.f, 0.f}, ab = {0.f, 0.f, 0.f, 0.f};
#pragma unroll
            for (int ks = 0; ks < 2; ++ks) { const bf16x8 Bf = *(const LAS bf16x8*)(KF + (s0 + i15) * 72 + 32 * ks + 8 * g), Bb = *(const LAS bf16x8*)(KB + (s0 + i15) * 72 + 32 * ks + 8 * g);
                af = MFMA16(Aqf[ks], Bf, af); ab = MFMA16(Aqb[ks], Bb, ab); }
#pragma unroll
            for (int r = 0; r < 4; ++r) { const int t = t0 + 4 * g + r, s = s0 + i15; const float v = (s <= t ? af[r] : 0.f) + (s >= t ? ab[r] : 0.f); AS[t * 72 + s] = (bf16)f2bf(v); } }
    }
    __syncthreads();
    {
        bf16x8 Aa[2], Aqf[2], Aqb[2];
#pragma unroll
        for (int ks = 0; ks < 2; ++ks) { Aa[ks] = *(const LAS bf16x8*)(AS + (t0 + i15) * 72 + 32 * ks + 8 * g); Aqf[ks] = *(const LAS bf16x8*)(QF + (t0 + i15) * 72 + 32 * ks + 8 * g); Aqb[ks] = *(const LAS bf16x8*)(QB + (t0 + i15) * 72 + 32 * ks + 8 * g); }
#pragma unroll
        for (int dt = 0; dt < 4; ++dt) { const int dv0 = dvb + 16 * dt; f32x4 acc = {0.f, 0.f, 0.f, 0.f};
#pragma unroll
            for (int ks = 0; ks < 2; ++ks) { const LAS unsigned char* p1 = (const LAS unsigned char*)Vs + (32 * ks + 8 * g + q4) * 288 + (dv0 + 4 * pp) * 2; const bf16x8 Bv = tr2(p1, p1 + 4 * 288); acc = MFMA16(Aa[ks], Bv, acc);
                acc = MFMA16(Aqf[ks], Bsf[dt][ks], acc); acc = MFMA16(Aqb[ks], Bsb[dt][ks], acc); }
#pragma unroll
            for (int r = 0; r < 4; ++r) Os[(t0 + 4 * g + r) * 128 + dv0 + i15] = acc[r]; }
    }
    __syncthreads();
    {
        const int t = rpos, d0 = (tid & 7) * 16; float o[16]; float ss = 0.f;
#pragma unroll
        for (int j = 0; j < 16; ++j) { o[j] = Os[t * 128 + d0 + j]; ss += o[j] * o[j]; }
        ss += __shfl_xor(ss, 1); ss += __shfl_xor(ss, 2); ss += __shfl_xor(ss, 4);
        const float r = rsqrtf(ss * (1.f / 128.f) + EPS);
        float gv[16];
#pragma unroll
        for (int w = 0; w < 4; ++w) { gv[2 * w] = bflo(g0[w]); gv[2 * w + 1] = bfhi(g0[w]); gv[8 + 2 * w] = bflo(g1[w]); gv[9 + 2 * w] = bfhi(g1[w]); }
#pragma unroll
        for (int j = 0; j < 16; ++j) o[j] = o[j] * r * onorm[d0 + j] * silu_f(gv[j]);
        u32x4 w0, w1; w0.x = pk2(o[0], o[1]); w0.y = pk2(o[2], o[3]); w0.z = pk2(o[4], o[5]); w0.w = pk2(o[6], o[7]); w1.x = pk2(o[8], o[9]); w1.y = pk2(o[10], o[11]); w1.z = pk2(o[12], o[13]); w1.w = pk2(o[14], o[15]);
        bf16* dst = MX + (size_t)(tok0 + t) * DM + h * 128 + d0; *(u32x4*)dst = w0; *(u32x4*)(dst + 8) = w1;
    }
    __syncthreads();
}

__device__ __forceinline__ void sg_unit(int unit, const bf16* P, const float* vng, const bf16* SGW, const float* bs, bf16* MX, LAS unsigned char* L, int tid, int wave, int lane) {
    const int g4 = unit & 3; int tok0;
    if (unit < 512) { const int b = unit >> 6, j = (unit >> 2) & 15; tok0 = b * 2048 + 128 * j; } else { const int u2 = unit - 512, b = u2 >> 3, j = (u2 >> 2) & 1; tok0 = NTX + b * 256 + 128 * j; }
    LAS bf16* VN = (LAS bf16*)L;
    const int g = lane >> 4, i15 = lane & 15, q4 = i15 >> 2, pp = i15 & 3, t0 = 16 * wave;
    bf16x8 Aw[4];
#pragma unroll
    for (int ks = 0; ks < 4; ++ks) Aw[ks] = *(const bf16x8*)(SGW + ((size_t)g4 * 128 + t0 + i15) * 128 + 32 * ks + 8 * g);
    float bsv[4];
#pragma unroll
    for (int r = 0; r < 4; ++r) bsv[r] = bs[g4 * 128 + t0 + 4 * g + r];
    bf16 uraw[8][4];
    { const int g_ = lane >> 4, i15_ = lane & 15;
#pragma unroll
      for (int ct = 0; ct < 8; ++ct)
#pragma unroll
        for (int r = 0; r < 4; ++r) uraw[ct][r] = P[(size_t)(tok0 + 16 * wave + 4 * g_ + r) * EVW + 1568 + g4 * 128 + 16 * ct + i15_]; }
    {   const int pos = tid >> 2, part = tid & 3; const bf16* sp = P + (size_t)(tok0 + pos) * EVW + 2080 + g4 * 128 + part * 32;
        float x[32]; float ss = 0.f;
#pragma unroll
        for (int q = 0; q < 4; ++q) { const u32x4 w = *(const u32x4*)(sp + 8 * q);
#pragma unroll
            for (int e = 0; e < 4; ++e) { const float a0 = gelu_f(bflo(w[e])), a1 = gelu_f(bfhi(w[e])); x[8 * q + 2 * e] = a0; x[8 * q + 2 * e + 1] = a1; ss += a0 * a0 + a1 * a1; } }
        ss += __shfl_xor(ss, 1); ss += __shfl_xor(ss, 2);
        const float r = rsqrtf(ss * (1.f / 128.f) + EPS); const float* gp = vng + g4 * 128 + part * 32;
#pragma unroll
        for (int q = 0; q < 4; ++q) { u32x4 w;
#pragma unroll
            for (int e = 0; e < 4; ++e) w[e] = pk2(x[8 * q + 2 * e] * r * gp[8 * q + 2 * e], x[8 * q + 2 * e + 1] * r * gp[8 * q + 2 * e + 1]);
            *(LAS u32x4*)(VN + pos * 144 + part * 32 + 8 * q) = w; }
    }
    __syncthreads();
#pragma unroll
    for (int ct = 0; ct < 8; ++ct) { f32x4 acc = {0.f, 0.f, 0.f, 0.f};
#pragma unroll
        for (int ks = 0; ks < 4; ++ks) { const LAS unsigned char* p1 = (const LAS unsigned char*)VN + (32 * ks + 8 * g + q4) * 288 + (16 * ct + 4 * pp) * 2; const bf16x8 Bf = tr2(p1, p1 + 4 * 288); acc = MFMA16(Aw[ks], Bf, acc); }
#pragma unroll
        for (int r = 0; r < 4; ++r) { const size_t tok = (size_t)(tok0 + t0 + 4 * g + r); const int cc = g4 * 128 + 16 * ct + i15;
            const float uv = bf2f(uraw[ct][r]); MX[tok * DM + 512 + cc] = (bf16)f2bf(gelu_f(uv) * (acc[r] + bsv[r])); } }
    __syncthreads();
}

__device__ __forceinline__ void mla_finalize(const bf16* QA, const bf16* KVA, const bf16* KPE, bf16* YQ, bf16* YKV, bf16* KK, const float* qn_g, const float* kn_g, int wave, int lane) {
    const int gw = blockIdx.x * 8 + wave, NGW = gridDim.x * 8;
    const float qg0 = qn_g[lane], qg1 = qn_g[64 + lane], qg2 = qn_g[128 + lane], kg0 = kn_g[lane], kg1 = kn_g[64 + lane], kg2 = kn_g[128 + lane];
    const int half = (lane >> 4) & 1; const float invf = exp2f(-(float)(lane & 15) * (13.287712379549449f / 16.0f));
    for (int tok = gw; tok < NTOK; tok += NGW) {
        bf16* qp = YQ + (size_t)tok * 1152; bf16* kvp = YKV + (size_t)tok * 1536; bf16* kp = KK + (size_t)tok * 1152;
        unsigned wq[3], wk[2];
#pragma unroll
        for (int j = 0; j < 3; ++j) wq[j] = *(const unsigned*)(QA + (size_t)tok * 384 + 2 * lane + 128 * j);
#pragma unroll
        for (int j = 0; j < 2; ++j) wk[j] = *(const unsigned*)(KVA + (size_t)tok * 256 + 2 * lane + 128 * j);
        const float kpe = bf2f(KPE[(size_t)tok * 64 + lane]);
        float y[6][3], kv[6][4];
#pragma unroll
        for (int h = 0; h < 6; ++h) { y[h][0] = bf2f(qp[h * 192 + lane]); y[h][1] = bf2f(qp[h * 192 + 64 + lane]); y[h][2] = bf2f(qp[h * 192 + 128 + lane]);
            kv[h][0] = bf2f(kvp[h * 256 + lane]); kv[h][1] = bf2f(kvp[h * 256 + 64 + lane]); kv[h][2] = bf2f(kvp[h * 256 + 128 + lane]); kv[h][3] = bf2f(kvp[h * 256 + 192 + lane]); }
        float sq = 0.f, sk = 0.f;
#pragma unroll
        for (int j = 0; j < 3; ++j) { const float a = bflo(wq[j]), b = bfhi(wq[j]); sq += a * a + b * b; }
#pragma unroll
        for (int j = 0; j < 2; ++j) { const float a = bflo(wk[j]), b = bfhi(wk[j]); sk += a * a + b * b; }
        const float rq = rsqrtf(wave_sum(sq) * (1.f / 384.f) + EPS), rk = rsqrtf(wave_sum(sk) * (1.f / 256.f) + EPS);
        float cs = 1.f, sn = 0.f;
        if (tok < NTX) { const int t = tok & 2047; const float pos = (float)((lane >> 5) ? (t & 63) : (t >> 6)); sincosf(pos * invf, &sn, &cs); }
        float sqh[6], skh[6];
#pragma unroll
        for (int h = 0; h < 6; ++h) { y[h][0] *= rq; y[h][1] *= rq; y[h][2] *= rq; kv[h][0] *= rk; kv[h][1] *= rk; kv[h][2] *= rk; kv[h][3] *= rk;
            sqh[h] = y[h][0] * y[h][0] + y[h][1] * y[h][1] + y[h][2] * y[h][2]; skh[h] = kv[h][0] * kv[h][0] + kv[h][1] * kv[h][1] + kpe * kpe; }
#pragma unroll
        for (int o = 1; o < 64; o <<= 1)
#pragma unroll
            for (int h = 0; h < 6; ++h) { sqh[h] += __shfl_xor(sqh[h], o); skh[h] += __shfl_xor(skh[h], o); }
#pragma unroll
        for (int h = 0; h < 6; ++h) {
            float r = rsqrtf(sqh[h] * (1.f / 192.f) + EPS);
            r *= 0.07216878364870322f * 1.4426950408889634f;
            float y0 = y[h][0] * r * qg0, y1 = y[h][1] * r * qg1, y2 = y[h][2] * r * qg2;
            { const float pr = __shfl_xor(y2, 16); const float rot = half ? pr : -pr; y2 = y2 * cs + rot * sn; }
            qp[h * 192 + lane] = (bf16)f2bf(y0); qp[h * 192 + 64 + lane] = (bf16)f2bf(y1); qp[h * 192 + 128 + lane] = (bf16)f2bf(y2);
            r = rsqrtf(skh[h] * (1.f / 192.f) + EPS);
            float k0 = kv[h][0] * r * kg0, k1 = kv[h][1] * r * kg1, k2 = kpe * r * kg2;
            { const float pr = __shfl_xor(k2, 16); const float rot = half ? pr : -pr; k2 = k2 * cs + rot * sn; }
            kp[h * 192 + lane] = (bf16)f2bf(k0); kp[h * 192 + 64 + lane] = (bf16)f2bf(k1); kp[h * 192 + 128 + lane] = (bf16)f2bf(k2);
            kvp[h * 256 + 128 + lane] = (bf16)f2bf(kv[h][2]); kvp[h * 256 + 192 + lane] = (bf16)f2bf(kv[h][3]);
        }
    }
}

__device__ __forceinline__ unsigned cvtpk(float lo, float hi) { unsigned r; asm("v_cvt_pk_bf16_f32 %0, %1, %2" : "=v"(r) : "v"(lo), "v"(hi)); return r; }
__device__ __forceinline__ void attn_unit(int unit, const bf16* Q, const bf16* KK, const bf16* YKV, bf16* MX, LAS unsigned char* L, int tid, int wave, int lane) {
    int b, h, qtok0, ntiles;
    if (unit < 384) { b = unit / 48; h = (unit >> 3) % 6; qtok0 = b * 2048 + (unit & 7) * 256; ntiles = 36; }
    else { const int u2 = unit - 384; b = u2 / 6; h = u2 % 6; qtok0 = NTX + b * 256; ntiles = 4; }
    const int g = lane >> 4, i15 = lane & 15, q4 = i15 >> 2, pp = i15 & 3;
    bf16x8 qf[2][6];
#pragma unroll
    for (int r = 0; r < 2; ++r) { const bf16* qp = Q + (size_t)(qtok0 + 32 * wave + 16 * r + i15) * 1152 + h * 192 + 8 * g;
#pragma unroll
      for (int ks = 0; ks < 6; ++ks) qf[r][ks] = *(const bf16x8*)(qp + 32 * ks); }
    int koff, voff;
    { const int r = 8 * wave + (lane >> 3), c = (lane & 7) ^ ((r >> 1) & 7); koff = r * 1152 + h * 192 + c * 8; }
    { const int r = 4 * wave + (lane >> 4), sl = lane & 15, dt = (sl >> 1) ^ (r & 7), c = 2 * dt + (sl & 1); voff = r * 1536 + h * 256 + 128 + c * 8; }
#define ATT_ISSUE(j, slot) do { const int kt0_ = (j) < 4 ? NTX + b * 256 + 64 * (j) : b * 2048 + 64 * ((j) - 4); \
        const bf16* kg_ = KK + (size_t)kt0_ * 1152 + koff; const bf16* vg_ = YKV + (size_t)kt0_ * 1536 + voff; LAS unsigned char* lb_ = L + (slot) * 40960 + wave * 1024; \
        __builtin_amdgcn_global_load_lds((const unsigned*)kg_, (LAS unsigned*)lb_, 16, 0, 0); \
        __builtin_amdgcn_global_load_lds((const unsigned*)(kg_ + 64), (LAS unsigned*)(lb_ + 8192), 16, 0, 0); \
        __builtin_amdgcn_global_load_lds((const unsigned*)(kg_ + 128), (LAS unsigned*)(lb_ + 16384), 16, 0, 0); \
        __builtin_amdgcn_global_load_lds((const unsigned*)vg_, (LAS unsigned*)(lb_ + 24576), 16, 0, 0); \
        __builtin_amdgcn_global_load_lds((const unsigned*)(vg_ + 32 * 1536), (LAS unsigned*)(lb_ + 24576 + 8192), 16, 0, 0); } while (0)
    const int kx = i15 >> 1, ka0 = i15 * 128 + ((g ^ kx) * 16), ka1 = i15 * 128 + (((4 + g) ^ kx) * 16);
    const int vbase = (4 * g + q4) * 256 + 8 * pp + ((4 * (g & 1) + q4) * 32);
    ATT_ISSUE(0, 0);
    f32x4 oacc[2][8];
#pragma unroll
    for (int r = 0; r < 2; ++r)
#pragma unroll
        for (int dt = 0; dt < 8; ++dt) oacc[r][dt] = (f32x4){0.f, 0.f, 0.f, 0.f};
    float mrun[2] = {0.f, 0.f}; f32x4 lacc[2] = {(f32x4){0.f, 0.f, 0.f, 0.f}, (f32x4){0.f, 0.f, 0.f, 0.f}};
    const bf16x8 ones = {16256, 16256, 16256, 16256, 16256, 16256, 16256, 16256};
    for (int j = 0; j < ntiles; ++j) {
        asm volatile("s_waitcnt vmcnt(0)" ::: "memory");
        __syncthreads();
        if (j + 1 < ntiles) ATT_ISSUE(j + 1, (j + 1) & 1);
        const LAS unsigned char* Kb = L + (j & 1) * 40960; const LAS unsigned char* Vb = Kb + 24576;
        f32x4 s[2][4];
#pragma unroll
        for (int T = 0; T < 4; ++T) { s[0][T] = (f32x4){-mrun[0], -mrun[0], -mrun[0], -mrun[0]}; s[1][T] = (f32x4){-mrun[1], -mrun[1], -mrun[1], -mrun[1]}; }
#define KFRAG(T_, ks_) (*(const LAS bf16x8*)(Kb + ((ks_) >> 1) * 8192 + (T_) * 2048 + (((ks_) & 1) ? ka1 : ka0)))
        bf16x8 kc[3], kn[3];
        kc[0] = KFRAG(0, 0); kc[1] = KFRAG(0, 1); kc[2] = KFRAG(0, 2);
#pragma unroll
        for (int hb = 0; hb < 8; ++hb) { const int T = hb >> 1, k0 = (hb & 1) * 3;
            if (hb < 7) { const int T2 = (hb + 1) >> 1, k2 = ((hb + 1) & 1) * 3; kn[0] = KFRAG(T2, k2); kn[1] = KFRAG(T2, k2 + 1); kn[2] = KFRAG(T2, k2 + 2); }
            __builtin_amdgcn_sched_barrier(0);
#pragma unroll
            for (int i = 0; i < 3; ++i) { s[0][T] = MFMA16(kc[i], qf[0][k0 + i], s[0][T]); s[1][T] = MFMA16(kc[i], qf[1][k0 + i], s[1][T]); }
            __builtin_amdgcn_sched_barrier(0);
            kc[0] = kn[0]; kc[1] = kn[1]; kc[2] = kn[2]; }
#undef KFRAG
#define VFRAG(dt_, k2_) tr2(Vb + (k2_) * 8192 + (vbase ^ ((dt_) << 5)), Vb + (k2_) * 8192 + (vbase ^ ((dt_) << 5)) + 4096)
        bf16x8 vc[2], vn[2];
        vc[0] = VFRAG(0, 0); vc[1] = VFRAG(0, 1);
        bf16x8 pf[2][2]; float mxr[2];
#pragma unroll
        for (int r = 0; r < 2; ++r) {
            float mx = s[r][0][0];
#pragma unroll
            for (int T = 0; T < 4; ++T)
#pragma unroll
                for (int e = 0; e < 4; ++e) mx = fmaxf(mx, s[r][T][e]);
            mx = fmaxf(mx, __shfl_xor(mx, 16)); mx = fmaxf(mx, __shfl_xor(mx, 32)); mxr[r] = mx;
        }
        if (__any((mxr[0] > 8.0f) || (mxr[1] > 8.0f))) {
#pragma unroll
            for (int r = 0; r < 2; ++r) { const float d = mxr[r] > 8.0f ? mxr[r] : 0.f, al = __builtin_amdgcn_exp2f(-d); mrun[r] += d;
#pragma unroll
                for (int T = 0; T < 4; ++T) s[r][T] = s[r][T] - d;
#pragma unroll
                for (int dt = 0; dt < 8; ++dt) oacc[r][dt] = oacc[r][dt] * al;
                lacc[r] = lacc[r] * al; }
        }
#pragma unroll
        for (int r = 0; r < 2; ++r) { u32x4 pw[2];
#pragma unroll
            for (int T = 0; T < 4; ++T) { float p[4];
#pragma unroll
                for (int e = 0; e < 4; ++e) p[e] = __builtin_amdgcn_exp2f(s[r][T][e]);
                pw[T >> 1][2 * (T & 1)] = cvtpk(p[0], p[1]); pw[T >> 1][2 * (T & 1) + 1] = cvtpk(p[2], p[3]); }
            pf[r][0] = __builtin_bit_cast(bf16x8, pw[0]); pf[r][1] = __builtin_bit_cast(bf16x8, pw[1]);
            lacc[r] = MFMA16(ones, pf[r][0], lacc[r]); lacc[r] = MFMA16(ones, pf[r][1], lacc[r]);
        }
#pragma unroll
        for (int dt = 0; dt < 8; ++dt) {
            if (dt < 7) { vn[0] = VFRAG(dt + 1, 0); vn[1] = VFRAG(dt + 1, 1); }
            __builtin_amdgcn_sched_barrier(0);
            oacc[0][dt] = MFMA16(vc[0], pf[0][0], oacc[0][dt]); oacc[1][dt] = MFMA16(vc[0], pf[1][0], oacc[1][dt]);
            oacc[0][dt] = MFMA16(vc[1], pf[0][1], oacc[0][dt]); oacc[1][dt] = MFMA16(vc[1], pf[1][1], oacc[1][dt]);
            __builtin_amdgcn_sched_barrier(0);
            vc[0] = vn[0]; vc[1] = vn[1]; }
#undef VFRAG
    }
#undef ATT_ISSUE
#pragma unroll
    for (int r = 0; r < 2; ++r) { const float inv = 1.f / lacc[r][0];
        bf16* op = MX + (size_t)(qtok0 + 32 * wave + 16 * r + i15) * DM + 256 + h * 128 + 4 * g;
#pragma unroll
        for (int dt = 0; dt < 8; ++dt) { u32x2 o; o.x = cvtpk(oacc[r][dt][0] * inv, oacc[r][dt][1] * inv); o.y = cvtpk(oacc[r][dt][2] * inv, oacc[r][dt][3] * inv); *(u32x2*)(op + 16 * dt) = o; } }
    __syncthreads();
}

#ifndef REP_PRO
#define REP_PRO 1
#endif
#ifndef REP_NORM
#define REP_NORM 1
#endif
#ifndef REP_G1
#define REP_G1 1
#endif
#ifndef REP_GLA
#define REP_GLA 1
#endif
#ifndef REP_GLAC
#define REP_GLAC 1
#endif
#ifndef REP_G2
#define REP_G2 1
#endif
#ifndef REP_G3
#define REP_G3 1
#endif
#ifndef REP_FIN
#define REP_FIN 1
#endif
#ifndef REP_FOUR
#define REP_FOUR 1
#endif
#ifndef REP_ATT
#define REP_ATT 1
#endif
#ifndef REP_G4L0
#define REP_G4L0 1
#endif
#ifndef REP_G4
#define REP_G4 1
#endif
#ifndef REP_G5
#define REP_G5 1
#endif
#ifndef REP_G6
#define REP_G6 1
#endif
#ifndef EXTRA_SYNCS
#define EXTRA_SYNCS 0
#endif
#ifndef EN_PRO
#define EN_PRO 1
#endif
#ifndef EN_NORM
#define EN_NORM 1
#endif
#ifndef EN_G1
#define EN_G1 1
#endif
#ifndef EN_GLA
#define EN_GLA 1
#endif
#ifndef EN_GLAC
#define EN_GLAC 1
#endif
#ifndef EN_G2
#define EN_G2 1
#endif
#ifndef EN_G3
#define EN_G3 1
#endif
#ifndef EN_FIN
#define EN_FIN 1
#endif
#ifndef EN_FOUR
#define EN_FOUR 1
#endif
#ifndef EN_ATT
#define EN_ATT 1
#endif
#ifndef EN_G4
#define EN_G4 1
#endif
#ifndef EN_G5
#define EN_G5 1
#endif
#ifndef EN_G6
#define EN_G6 1
#endif

constexpr int N_PHASES = 37;
__device__ __forceinline__ bool in_phase(LAS unsigned char* L, int k) { const LAS unsigned* p = (const LAS unsigned*)(L + 131072) + 58; const int lo = (int)__builtin_amdgcn_readfirstlane(p[0]), hi = (int)__builtin_amdgcn_readfirstlane(p[1]); return lo <= k && k < hi; }
__global__ void __launch_bounds__(512, 2) mk_fwd(Args a) {
    extern __shared__ __attribute__((aligned(16))) unsigned char lds_raw[];
    LAS unsigned char* L = (LAS unsigned char*)lds_raw;
    cg::grid_group grid = cg::this_grid();
    { const int tid = threadIdx.x;
    if (tid < 29) { const unsigned long long v = tid < 27 ? (unsigned long long)a.in[tid] : (tid == 27 ? (unsigned long long)a.out : (unsigned long long)a.ws);
        ((LAS unsigned*)(L + 131072))[2 * tid] = (unsigned)v; ((LAS unsigned*)(L + 131072))[2 * tid + 1] = (unsigned)(v >> 32); } }
    if (threadIdx.x == 0) { ((LAS unsigned*)(L + 131072))[58] = (unsigned)a.ph_lo; ((LAS unsigned*)(L + 131072))[59] = (unsigned)a.ph_hi; }
    if (threadIdx.x < 2) ((LAS unsigned*)(L + 131072 + 512))[threadIdx.x] = 0u;
    __syncthreads();
    (void)xcd_barrier_post((unsigned*)a.ws, (volatile LAS unsigned*)(L + 131072 + 512));
    const bool lo_dead = a.ph_lo < 0;
#define IN(k) in_phase(L, (k))
#define SEAM(k) do { if (IN(k) && IN((k) + 1)) { if (lo_dead) grid.sync(); else { XcdBarrier xb_; xb_.bar = (unsigned*)WSP; xb_.x = xb_xcc_id(); xb_.st = (volatile LAS unsigned*)(L + 131072 + 512); xcd_barrier(xb_); for (int xs_ = 0; xs_ < EXTRA_SYNCS; ++xs_) xcd_barrier(xb_); } } } while (0)
#define TID_VARS int tid = threadIdx.x; asm volatile("" : "+v"(tid)); const int lane = tid & 63, wave = __builtin_amdgcn_readfirstlane(tid >> 6); (void)lane; (void)wave;
#define LAYER_VARS TID_VARS int l = lc; asm volatile("" : "+s"(l)); const int i2 = l >> 1; const bool need_ctx = l < 3; const int mtok = need_ctx ? NTOK : NTX; unsigned char* ws = WSP; const int G = gridDim.x, bid = blockIdx.x; \
        float* MOD = (float*)(ws + WS_MOD); const float* mod = MOD + (size_t)l * 9 * 6144; bf16* ZX = (bf16*)(ws + WS_ZX); float* HB = (float*)(ws + WS_H); (void)i2; (void)need_ctx; (void)mtok; (void)G; (void)bid; (void)mod; (void)ZX; (void)HB;
    for (int rep_ = 0; rep_ < REP_PRO; ++rep_) if (EN_PRO && IN(0)) { TID_VARS prologue(L, tid, wave, lane); }
    SEAM(0);
#pragma nounroll
    for (int lc = 0; lc < 4; ++lc) {
        const int p0 = 1 + 9 * lc; const bool odd = lc & 1;
        for (int rep_ = 0; rep_ < REP_NORM; ++rep_) if (EN_NORM && IN(p0)) { LAYER_VARS const float* xin = l == 0 ? INP(0) : OUTP; const float* hin = l == 0 ? INP(2) : HB; norm_phase(xin, hin, INP(6) + l * DM, mod, 0, 1, ZX, NTOK, wave, lane, l > 0 ? (const bf16*)(ws + WS_R2) : nullptr, HB); }
        SEAM(p0);
        if (!odd) {
            for (int rep_ = 0; rep_ < REP_G1; ++rep_) if (EN_G1 && IN(p0 + 1)) { LAYER_VARS bf16* P = (bf16*)(ws + WS_R1);
                pg8::Gemm g{ZX, (const bf16*)(ws + WS_WEV) + (size_t)i2 * EVP * 1024, NTOK, EVP, 1024}; pg8::StaticOrder S; S.init(NTOK, EVP, G, bid);
                EpiStore E{P, EVW, EVW}; pg8::gemm_phase<EpiStore, pg8::StaticOrder, true, true>(L, g, S, E); }
            SEAM(p0 + 1);
            for (int rep_ = 0; rep_ < REP_GLA; ++rep_) if (EN_GLA && IN(p0 + 2)) { LAYER_VARS bf16* P = (bf16*)(ws + WS_R1); bf16* U = (bf16*)(ws + WS_R2 + R2_U); float* DD = (float*)(ws + WS_R2 + R2_DD);
                const float *waf = INP(12) + i2 * 4096, *baf = INP(13) + i2 * 256, *wab = INP(14) + i2 * 4096, *bab = INP(15) + i2 * 256;
                for (int u = bid; u < 1152 + 576; u += G) {
                    if (u < 1152) gla_passA(u, P, waf, baf, wab, bab, U, DD, L, tid, wave, lane);
                    else sg_unit(u - 1152, P, INP(17) + i2 * 512, (const bf16*)(ws + WS_SGW) + (size_t)i2 * 65536, INP(19) + i2 * 512, ZX, L, tid, wave, lane);
                } }
            SEAM(p0 + 2);
            for (int rep_ = 0; rep_ < REP_GLA; ++rep_) if (EN_GLA && IN(p0 + 3)) { LAYER_VARS gla_passB((const bf16*)(ws + WS_R2 + R2_U), (const float*)(ws + WS_R2 + R2_DD), (bf16*)(ws + WS_R2 + R2_SB), tid); }
            SEAM(p0 + 3);
            for (int rep_ = 0; rep_ < REP_GLAC; ++rep_) if (EN_GLAC && IN(p0 + 4)) { LAYER_VARS bf16* P = (bf16*)(ws + WS_R1); const bf16* SB = (const bf16*)(ws + WS_R2 + R2_SB);
                const float *waf = INP(12) + i2 * 4096, *baf = INP(13) + i2 * 256, *wab = INP(14) + i2 * 4096, *bab = INP(15) + i2 * 256;
                for (int u = bid; u < 1152; u += G) gla_passC(u, P, waf, baf, wab, bab, SB, INP(16) + i2 * 128, ZX, L, tid, wave, lane); }
            SEAM(p0 + 4);
        } else {
            for (int rep_ = 0; rep_ < REP_G2; ++rep_) if (EN_G2 && IN(p0 + 1)) { LAYER_VARS
                pg8::Gemm g{ZX, (const bf16*)(ws + WS_WOD) + (size_t)i2 * ODP * 1024, NTOK, ODP, 1024}; pg8::StaticOrder S; S.init(NTOK, ODP, G, bid);
                EpiOddIn E{(bf16*)(ws + WS_R1 + R1_QA), (bf16*)(ws + WS_R1 + R1_KVA), (bf16*)(ws + WS_R1 + R1_KPE), (bf16*)(ws + WS_R1 + R1_FBX), (bf16*)(ws + WS_R1 + R1_FBC)};
                pg8::gemm_phase<EpiOddIn, pg8::StaticOrder, true, true>(L, g, S, E); }
            SEAM(p0 + 1);
            for (int rep_ = 0; rep_ < REP_G3; ++rep_) if (EN_G3 && IN(p0 + 2)) {
#pragma nounroll
                for (int wq = 0; wq < 2; ++wq) { LAYER_VARS int w = wq; asm volatile("" : "+s"(w));
                    const bf16* A = (const bf16*)(ws + WS_R1 + (w ? R1_KVA : R1_QA)); const bf16* Bt = w ? (const bf16*)(ws + WS_WUKV) + (size_t)i2 * 1536 * 256 : (const bf16*)(ws + WS_WUQ) + (size_t)i2 * 1280 * 384;
                    const int Kk = w ? 256 : 384, Np = w ? 1536 : 1280, Nv = w ? 1536 : 1152; bf16* O = w ? (bf16*)(ws + WS_R2 + R2_YKV) : (bf16*)(ws + WS_R1 + R1_YQ);
                    pg8::Gemm g{A, Bt, NTOK, Np, Kk}; pg8::StaticOrder S; S.init(NTOK, Np, G, bid);
                    EpiStore E{O, Nv, Nv}; pg8::gemm_phase<EpiStore, pg8::StaticOrder, true, true>(L, g, S, E); } }
            SEAM(p0 + 2);
            for (int rep_ = 0; rep_ < REP_FIN; ++rep_) if (EN_FIN && IN(p0 + 3)) { LAYER_VARS mla_finalize((bf16*)(ws + WS_R1 + R1_QA), (bf16*)(ws + WS_R1 + R1_KVA), (bf16*)(ws + WS_R1 + R1_KPE), (bf16*)(ws + WS_R1 + R1_YQ), (bf16*)(ws + WS_R2 + R2_YKV), (bf16*)(ws + WS_R2 + R2_KK), INP(25) + i2 * 192, INP(26) + i2 * 192, wave, lane); }
            SEAM(p0 + 3);
            for (int rep_ = 0; rep_ < REP_FOUR; ++rep_) if (EN_FOUR && IN(p0 + 4)) {
#pragma nounroll
                for (int wq = 0; wq < 2; ++wq) { LAYER_VARS int w = wq; asm volatile("" : "+s"(w)); const int NF = G >= 128 ? 64 : G;
                    if (bid < NF && (w == 0 || need_ctx)) {
                        const bf16* A = (const bf16*)(ws + (w ? WS_DFTC : WS_DFTX)); const bf16* Bt = (const bf16*)(ws + WS_R1 + (w ? R1_FBC : R1_FBX));
                        const int Mm = w ? 256 : 2048, Kk = w ? 512 : 4096;
                        pg8::Gemm g{A, Bt, Mm, 2048, Kk}; pg8::StaticOrder S; S.init(Mm, 2048, NF, bid);
                        EpiFourier E{ZX, w ? NTX : 0, Mm, w ? 0.0078125f : 0.00276213586400995f}; pg8::gemm_phase<EpiFourier, pg8::StaticOrder, true, true>(L, g, S, E); } } }
            for (int rep_ = 0; rep_ < REP_ATT; ++rep_) if (EN_ATT && IN(p0 + 4)) { LAYER_VARS const int NF = G >= 128 ? 64 : 0, GA = G - NF, ba = bid - NF;
                const int nun = need_ctx ? 432 : 384;
                if (ba >= 0) for (int v = ba; v < nun; v += GA) { int u = v;
                    if (G == 256) { const int x = v & 7, li = (v % 192) >> 3, i = v / 192; if (i < 2) { const int lu = li + 24 * i; u = (x + 8 * (lu >> 3)) * 8 + (lu & 7); } else u = 384 + x + 8 * li; }
                    attn_unit(u, (bf16*)(ws + WS_R1 + R1_YQ), (bf16*)(ws + WS_R2 + R2_KK), (bf16*)(ws + WS_R2 + R2_YKV), ZX, L, tid, wave, lane); } }
            SEAM(p0 + 4);
        }
        for (int rep_ = 0; rep_ < (lc == 0 ? REP_G4L0 : REP_G4); ++rep_) if (EN_G4 && IN(p0 + 5)) { LAYER_VARS const float* xin = l == 0 ? INP(0) : OUTP; const float* hin = l == 0 ? INP(2) : HB;
            pg8::Gemm g{ZX, (const bf16*)(ws + WS_WMIX) + (size_t)l * DM * DM, mtok, DM, DM};
            pg8::TailOrder S; S.init(DM, G, bid, need_ctx ? 256 : 0); EpiResid E{xin, hin, OUTP, HB, mod + 2 * 1024, (bf16*)(ws + WS_R2)}; pg8::gemm_phase<EpiResid, pg8::TailOrder, true, true>(L, g, S, E); }
        SEAM(p0 + 5);
        for (int rep_ = 0; rep_ < REP_NORM; ++rep_) if (EN_NORM && IN(p0 + 6)) { LAYER_VARS { const float* hin = l == 0 ? INP(2) : HB; norm_phase(OUTP, hin, INP(7) + l * DM, mod, 3, 4, ZX, mtok, wave, lane, need_ctx ? (const bf16*)(ws + WS_R2) : nullptr, HB); } }
        SEAM(p0 + 6);
        for (int rep_ = 0; rep_ < REP_G5; ++rep_) if (EN_G5 && IN(p0 + 7)) { LAYER_VARS
            pg8::Gemm g{ZX, (const bf16*)(ws + WS_WFI) + (size_t)l * 5632 * 1024, mtok, 5632, 1024}; pg8::StaticOrder S; S.init(mtok, 5632, G, bid);
            EpiSwiglu E{(bf16*)(ws + WS_R1)}; pg8::gemm_phase<EpiSwiglu, pg8::StaticOrder, true, true>(L, g, S, E); }
        SEAM(p0 + 7);
        for (int rep_ = 0; rep_ < REP_G6; ++rep_) if (EN_G6 && IN(p0 + 8)) { LAYER_VARS float* outp = OUTP;
            pg8::Gemm g{(bf16*)(ws + WS_R1), (const bf16*)(ws + WS_WFO) + (size_t)l * DM * FF, mtok, DM, FF};
            pg8::TailOrder S; S.init(FF, G, bid, need_ctx ? 256 : 0); EpiResid E{outp, HB, outp, HB, mod + 5 * 1024, (bf16*)(ws + WS_R2)}; pg8::gemm_phase<EpiResid, pg8::TailOrder, true, true>(L, g, S, E); }
        SEAM(p0 + 8);
    }
#undef IN
#undef SEAM
}

#ifndef MK_PER_PHASE
#define MK_PER_PHASE 0
#endif
extern "C" void kernel_launch(void* const* d_in, const int* in_sizes, int n_in, void* d_out, int out_size, void* d_ws, size_t ws_size, hipStream_t stream) {
    static int grid = 0;
    if (grid == 0) {
        if (n_in != 27 || ws_size < WS_END) { fprintf(stderr, "kernel_launch: need 27 inputs and >= %zu bytes of workspace (got %d, %zu)\n", (size_t)WS_END, n_in, ws_size); grid = -1; return; }
        int dev = 0, cus = 0, per_cu = 0;
        hipGetDevice(&dev); hipDeviceGetAttribute(&cus, hipDeviceAttributeMultiprocessorCount, dev);
        if (hipFuncSetAttribute((const void*)mk_fwd, hipFuncAttributeMaxDynamicSharedMemorySize, LDS_BYTES) != hipSuccess) { fprintf(stderr, "kernel_launch: hipFuncSetAttribute failed\n"); grid = -1; return; }
        if (hipOccupancyMaxActiveBlocksPerMultiprocessor(&per_cu, (const void*)mk_fwd, 512, LDS_BYTES) != hipSuccess || per_cu < 1) { fprintf(stderr, "kernel_launch: occupancy query says %d\n", per_cu); per_cu = 1; }
        (void)hipGetLastError();
        grid = cus * 1;
    }
    if (grid < 0) return;
    if (hipMemsetAsync(d_ws, 0, 16384, stream) != hipSuccess) { fprintf(stderr, "kernel_launch: memset of the barrier words failed\n"); return; }
    Args a{};
    for (int i = 0; i < 27; ++i) a.in[i] = (const float*)d_in[i];
    a.out = (float*)d_out; a.ws = (unsigned char*)d_ws;
#if MK_PER_PHASE
    for (int p = 0; p < N_PHASES; ++p) { a.ph_lo = p; a.ph_hi = p + 1; hipLaunchKernelGGL(mk_fwd, dim3(grid), dim3(512), LDS_BYTES, stream, a); }
#else
    a.ph_lo = 0; a.ph_hi = N_PHASES;
    void* args[] = {&a};
    hipError_t e = hipLaunchCooperativeKernel((const void*)mk_fwd, dim3(grid), dim3(512), args, LDS_BYTES, stream);
    if (e != hipSuccess) fprintf(stderr, "kernel_launch: cooperative launch failed: %s (grid %d)\n", hipGetErrorString(e), grid);
#endif
}
```

```cpp
#include <hip/hip_runtime.h>
#include <hip/hip_cooperative_groups.h>
#include <cstdio>
#include <cstdint>
#include <cmath>
namespace cg = cooperative_groups;
namespace pg8 {
#define PG8_LAS __attribute__((address_space(3)))
typedef unsigned short bf16_t;
typedef short bf16x8 __attribute__((ext_vector_type(8)));
typedef float f32x4 __attribute__((ext_vector_type(4)));
typedef unsigned u32x4 __attribute__((ext_vector_type(4)));
constexpr int BM = 256, BK = 64, HALF = 128, HTB = HALF * BK * 2  , STAGE_BYTES = 8 * HTB, NXCD = 8, WGM = 8;

__host__ __device__ __forceinline__ int lds_byte(int r, int c) { const int st = (r >> 4) * 2 + (c >> 5), rr = r & 15, cc = c & 31, ob = rr * 64 + cc * 2; return st * 1024 + (ob ^ (((ob >> 9) & 1) << 5)); }
__host__ __device__ __forceinline__ void stage_rc(int b, int& R, int& C) { const int st = b / 1024, sb = b % 1024, swz = sb ^ (((sb >> 9) & 1) << 5); R = (st >> 1) * 16 + swz / 64; C = (st & 1) * 32 + (swz % 64) / 2; }
__host__ __device__ __forceinline__ int perm32(int rho) { const int n = rho >> 4, i = rho & 15; return 8 * (i >> 2) + 4 * n + (i & 3); }

struct Unit { int pm, pn, kb, nt, ks; };
struct Gemm { const bf16_t* A; const bf16_t* Bt; int M, N, K; };

struct StaticOrder {
    int nM, nN, nwg, G, c;
    __host__ __device__ __forceinline__ void init(int M, int N, int G_, int c_) { nM = M / BM; nN = N / BM; nwg = nM * nN; G = G_; c = c_; }
    __host__ __device__ __forceinline__ bool next(int i, Unit& u) const {
        const long L = (long)i * G + c; if (L >= nwg) return false;
        int wgid = (int)L; { const int q = nwg / NXCD, r = nwg % NXCD, xcd = wgid % NXCD, off = wgid / NXCD; wgid = (xcd < r ? xcd * (q + 1) : r * (q + 1) + (xcd - r) * q) + off; }
        const int nig = WGM * nN, gid = wgid / nig, fm = gid * WGM, gsz = (nM - fm) < WGM ? (nM - fm) : WGM;
        u.pm = fm + ((wgid % nig) % gsz); u.pn = (wgid % nig) / gsz; u.kb = 0; u.nt = 0; u.ks = 0; return true;
    }
    __device__ __forceinline__ void a_ready(const Unit&) const {}
    __device__ __forceinline__ void done(const Unit&) const {}
};

__device__ __forceinline__ unsigned cvt_pk_bf16(float lo, float hi) { unsigned r; asm volatile("v_cvt_pk_bf16_f32 %0, %1, %2" : "=v"(r) : "v"(lo), "v"(hi)); return r; }
typedef float f32x2 __attribute__((ext_vector_type(2)));

struct TailOrder {
    StaticOrder so; int G, c, pairs, nw, ntail;
    __host__ __device__ __forceinline__ void init(int K, int G_, int c_, int ntail_) { so.init(16384, 1024, G_, c_); G = G_; c = c_; pairs = K / 128; nw = c_ < 256 ? (256 - c_ + G_ - 1) / G_ : 0; ntail = ntail_; }
    __host__ __device__ __forceinline__ bool next(int i, Unit& u) const {
        int pm = 0, pn = 0, kb = 0, nt = 0, ks = 0; bool ok;
        if (i < nw) {
            const int L0 = i * G + c; ok = L0 < 256; int wgid = L0 & 255; { const int xcd = wgid % NXCD, off = wgid / NXCD; wgid = xcd * 32 + off; }
            const int nig = WGM * 4, gid = wgid / nig, fm = gid * WGM; pm = fm + ((wgid % nig) % WGM); pn = (wgid % nig) / WGM;
        } else {
            const int j = (i - nw) * G + c; ok = j < ntail; const int tu = (j & 255) >> 3, s = j & 7, base = pairs >> 3, rem = pairs & 7;
            pm = 64 + (tu >> 2); pn = tu & 3; ks = s; nt = 2 * (base + (s < rem ? 1 : 0)); kb = 128 * (s * base + (s < rem ? s : rem));
        }
        u.pm = pm; u.pn = pn; u.kb = kb; u.nt = nt; u.ks = ks; return ok;
    }
    __device__ __forceinline__ void a_ready(const Unit&) const {}
    __device__ __forceinline__ void done(const Unit&) const {}
};

struct LdsOrder {
    __attribute__((address_space(3))) int* p;
    template <class S> __device__ __forceinline__ void fill(const S& s, int tid) {
        if (tid == 0) { for (int i = 0; i < 9; ++i) { Unit u; u.pm = 0; u.pn = 0; u.kb = 0; u.nt = 0; u.ks = 0; const bool ok = s.next(i, u); p[i * 8 + 0] = ok ? u.pm : -1; p[i * 8 + 1] = u.pn; p[i * 8 + 2] = u.kb; p[i * 8 + 3] = u.nt; p[i * 8 + 4] = u.ks; if (!ok) break; } }
        __syncthreads();
    }
    __device__ __forceinline__ bool next(int i, Unit& u) const {
        const int pm = __builtin_amdgcn_readfirstlane(p[i * 8 + 0]); if (pm < 0) return false;
        u.pm = pm; u.pn = __builtin_amdgcn_readfirstlane(p[i * 8 + 1]); u.kb = __builtin_amdgcn_readfirstlane(p[i * 8 + 2]); u.nt = __builtin_amdgcn_readfirstlane(p[i * 8 + 3]); u.ks = __builtin_amdgcn_readfirstlane(p[i * 8 + 4]); return true;
    }
    __device__ __forceinline__ void a_ready(const Unit&) const {}
    __device__ __forceinline__ void done(const Unit&) const {}
};
template <class Epi, class Sched, bool ALIGN_EPI = false, bool SP2 = false>
__device__ __forceinline__ void gemm_phase(PG8_LAS unsigned char* lds, const Gemm g, const Sched& S, const Epi& E) {
    int tid = threadIdx.x; asm volatile("" : "+v"(tid));
    const int wid = __builtin_amdgcn_readfirstlane(tid >> 6), lane = tid & 63, wr = wid >> 2, wc = wid & 3, fr = lane & 15, fq = lane >> 4;
    const int K = g.K, nt = K / BK;
    unsigned voffA[2], voffB[2];
#pragma unroll
    for (int i = 0; i < 2; ++i) { int R, C; stage_rc(tid * 16 + i * 8192, R, C); const int Rb = Epi::PERM ? ((R & ~31) + perm32(R & 31)) : R;
        voffA[i] = (unsigned)(R * K + C) * 2u; voffB[i] = (unsigned)(Rb * K + C) * 2u; }
    const size_t kstep = (size_t)(BK * 2);
    const size_t hstep = (size_t)HALF * K * 2;
    const size_t tstep = 2 * hstep;
    const unsigned ldsw = (unsigned)wid * 1024u;
    const int aoff = lds_byte(wr * 64 + fr, fq * 8), boff = lds_byte(wc * 32 + fr, fq * 8);
#define PG8_SA(b, h) (((b) * 2 + (h)) * HTB)
#define PG8_SB(b, h) ((4 + (b) * 2 + (h)) * HTB)
#define PG8_STAGE(bufoff, gbase, voff) do { _Pragma("unroll") for (int _i = 0; _i < 2; ++_i) \
        __builtin_amdgcn_global_load_lds((const unsigned*)((const char*)(gbase) + (voff)[_i]), (PG8_LAS unsigned*)(lds + (bufoff) + ldsw + _i * 8192), 16, 0, 0); } while (0)
#define PG8_LDA(dst, b, h) do { _Pragma("unroll") for (int m = 0; m < 4; ++m) _Pragma("unroll") for (int k = 0; k < 2; ++k) dst[m][k] = *(const PG8_LAS bf16x8*)(lds + PG8_SA(b, h) + aoff + m * 2048 + k * 1024); } while (0)
#define PG8_LDB(dst, b, h) do { _Pragma("unroll") for (int n = 0; n < 2; ++n) _Pragma("unroll") for (int k = 0; k < 2; ++k) dst[n][k] = *(const PG8_LAS bf16x8*)(lds + PG8_SB(b, h) + boff + n * 2048 + k * 1024); } while (0)
#define PG8_MMA(ai, bj, At, Bt) do { __builtin_amdgcn_s_setprio(1); _Pragma("unroll") for (int m = 0; m < 4; ++m) _Pragma("unroll") for (int n = 0; n < 2; ++n) _Pragma("unroll") for (int k = 0; k < 2; ++k) \
        acc[ai][bj][m][n] = __builtin_amdgcn_mfma_f32_16x16x32_bf16(Bt[n][k], At[m][k], acc[ai][bj][m][n], 0, 0, 0); __builtin_amdgcn_s_setprio(0); } while (0)
#define PG8_WAIT_V(n) asm volatile("s_waitcnt vmcnt(" #n ")" ::: "memory")
#define PG8_WAIT_L(n) asm volatile("s_waitcnt lgkmcnt(" #n ")" ::: "memory")
#define PG8_BAR __builtin_amdgcn_s_barrier()
#define PG8_SCHED __builtin_amdgcn_sched_barrier(0)
    Unit cur, nxt; int ui = 0;
    if (!S.next(0, cur)) return;
    f32x4 acc[2][2][4][2];
#pragma unroll
    for (int a = 0; a < 2; ++a)
#pragma unroll
        for (int b = 0; b < 2; ++b)
#pragma unroll
            for (int m = 0; m < 4; ++m)
#pragma unroll
                for (int n = 0; n < 2; ++n) acc[a][b][m][n] = (f32x4){0.f, 0.f, 0.f, 0.f};
    bf16x8 At[4][2], B0[2][2], B1[2][2];
    const char* cA = (const char*)g.A + (size_t)cur.pm * tstep + (size_t)cur.kb * 2; const char* cB = (const char*)g.Bt + (size_t)cur.pn * tstep + (size_t)cur.kb * 2;
    S.a_ready(cur);
    if constexpr (SP2) {
        PG8_STAGE(PG8_SB(0, 0), cB, voffB); PG8_STAGE(PG8_SB(0, 1), cB + hstep, voffB); PG8_STAGE(PG8_SA(0, 0), cA, voffA); PG8_STAGE(PG8_SA(0, 1), cA + hstep, voffA);
        if (wr == 1) PG8_BAR;
        PG8_WAIT_V(2); PG8_BAR;
        PG8_STAGE(PG8_SB(1, 0), cB + kstep, voffB); PG8_STAGE(PG8_SA(1, 0), cA + kstep, voffA); PG8_STAGE(PG8_SB(1, 1), cB + hstep + kstep, voffB);
        PG8_WAIT_V(6); PG8_BAR;
    } else {
        PG8_STAGE(PG8_SB(0, 0), cB, voffB); PG8_STAGE(PG8_SA(0, 0), cA, voffA); PG8_STAGE(PG8_SB(0, 1), cB + hstep, voffB); PG8_STAGE(PG8_SA(0, 1), cA + hstep, voffA);
        if (wr == 1) PG8_BAR;
        PG8_WAIT_V(4); PG8_BAR;
        PG8_STAGE(PG8_SB(1, 0), cB + kstep, voffB); PG8_STAGE(PG8_SA(1, 0), cA + kstep, voffA); PG8_STAGE(PG8_SB(1, 1), cB + hstep + kstep, voffB);
        PG8_WAIT_V(6); PG8_BAR;
    }
    for (;;) {
        const bool has_next = S.next(ui + 1, nxt);
        const char* nA = has_next ? (const char*)g.A + (size_t)nxt.pm * tstep + (size_t)nxt.kb * 2 : cA; const char* nB = has_next ? (const char*)g.Bt + (size_t)nxt.pn * tstep + (size_t)nxt.kb * 2 : cB;
        const int unt = cur.nt ? cur.nt : nt;
        for (int t = 0; t < unt; t += 2) {
            const bool last = (t == unt - 2);
            const char* a1 = cA + (size_t)(t + 1) * kstep;
            const char* a2 = last ? nA : cA + (size_t)(t + 2) * kstep; const char* b2 = last ? nB : cB + (size_t)(t + 2) * kstep;
            const char* a3 = a2 + kstep; const char* b3 = b2 + kstep;
            if (last && has_next) S.a_ready(nxt);
            if constexpr (SP2) {
            PG8_LDB(B0, 0, 0); PG8_LDB(B1, 0, 1); PG8_SCHED; PG8_LDA(At, 0, 0); PG8_STAGE(PG8_SA(1, 1), a1 + hstep, voffA);
            PG8_WAIT_V(8); PG8_WAIT_L(0); PG8_BAR; PG8_MMA(0, 0, At, B0); PG8_MMA(0, 1, At, B1); PG8_BAR; PG8_SCHED;
            PG8_LDA(At, 0, 1); PG8_STAGE(PG8_SB(0, 0), b2, voffB); PG8_STAGE(PG8_SB(0, 1), b2 + hstep, voffB); PG8_STAGE(PG8_SA(0, 0), a2, voffA);
            PG8_WAIT_V(8); PG8_WAIT_L(0); PG8_BAR; PG8_MMA(1, 0, At, B0); PG8_MMA(1, 1, At, B1); PG8_BAR; PG8_SCHED;
            PG8_LDB(B0, 1, 0); PG8_LDB(B1, 1, 1); PG8_SCHED; PG8_LDA(At, 1, 0); PG8_STAGE(PG8_SA(0, 1), a2 + hstep, voffA);
            PG8_WAIT_V(8); PG8_WAIT_L(0); PG8_BAR; PG8_MMA(0, 0, At, B0); PG8_MMA(0, 1, At, B1); PG8_BAR; PG8_SCHED;
            PG8_LDA(At, 1, 1); PG8_STAGE(PG8_SB(1, 0), b3, voffB); PG8_STAGE(PG8_SB(1, 1), b3 + hstep, voffB); PG8_STAGE(PG8_SA(1, 0), a3, voffA);
            PG8_WAIT_V(8); PG8_WAIT_L(0); PG8_BAR; PG8_MMA(1, 0, At, B0); PG8_MMA(1, 1, At, B1); PG8_BAR; PG8_SCHED;
            } else {
            PG8_LDB(B0, 0, 0); PG8_SCHED; PG8_LDA(At, 0, 0); PG8_STAGE(PG8_SA(1, 1), a1 + hstep, voffA);
            PG8_WAIT_L(8); PG8_BAR; PG8_WAIT_L(0); PG8_MMA(0, 0, At, B0); PG8_BAR; PG8_SCHED;
            PG8_LDB(B1, 0, 1); PG8_STAGE(PG8_SB(0, 0), b2, voffB);
            PG8_BAR; PG8_WAIT_L(0); PG8_MMA(0, 1, At, B1); PG8_BAR;
            PG8_LDA(At, 0, 1); PG8_STAGE(PG8_SA(0, 0), a2, voffA);
            PG8_BAR; PG8_WAIT_L(0); PG8_MMA(1, 0, At, B0); PG8_BAR; PG8_SCHED;
            PG8_STAGE(PG8_SB(0, 1), b2 + hstep, voffB);
            PG8_WAIT_V(6); PG8_BAR; PG8_MMA(1, 1, At, B1); PG8_BAR;
            PG8_LDB(B0, 1, 0); PG8_SCHED; PG8_LDA(At, 1, 0); PG8_STAGE(PG8_SA(0, 1), a2 + hstep, voffA);
            PG8_WAIT_L(8); PG8_BAR; PG8_WAIT_L(0); PG8_MMA(0, 0, At, B0); PG8_BAR; PG8_SCHED;
            PG8_LDB(B1, 1, 1); PG8_STAGE(PG8_SB(1, 0), b3, voffB);
            PG8_BAR; PG8_WAIT_L(0); PG8_MMA(0, 1, At, B1); PG8_BAR;
            PG8_LDA(At, 1, 1); PG8_STAGE(PG8_SA(1, 0), a3, voffA);
            PG8_BAR; PG8_WAIT_L(0); PG8_MMA(1, 0, At, B0); PG8_BAR; PG8_SCHED;
            PG8_STAGE(PG8_SB(1, 1), b3 + hstep, voffB);
            PG8_WAIT_V(6); PG8_BAR; PG8_MMA(1, 1, At, B1); PG8_BAR;
            }
        }
        if constexpr (ALIGN_EPI) { if (wr == 0) PG8_BAR; }
        if constexpr (!Epi::AFTER_DRAIN) { E(acc, cur, wr, wc, fr, fq); S.done(cur); }
        if (!has_next) break;
#pragma unroll
        for (int a = 0; a < 2; ++a)
#pragma unroll
            for (int b = 0; b < 2; ++b)
#pragma unroll
                for (int m = 0; m < 4; ++m)
#pragma unroll
                    for (int n = 0; n < 2; ++n) acc[a][b][m][n] = (f32x4){0.f, 0.f, 0.f, 0.f};
        cur = nxt; cA = nA; cB = nB; ++ui;
        if constexpr (ALIGN_EPI) { if (wr == 1) PG8_BAR; }
    }
    PG8_WAIT_V(0);
    if constexpr (!ALIGN_EPI) { if (wr == 0) PG8_BAR; }
    PG8_BAR;
    if constexpr (Epi::AFTER_DRAIN) { E.fused(acc, cur, wr, wc, fr, fq, lds, wid, lane); S.done(cur); }
#undef PG8_SA
#undef PG8_SB
#undef PG8_STAGE
#undef PG8_LDA
#undef PG8_LDB
#undef PG8_MMA
#undef PG8_WAIT_V
#undef PG8_WAIT_L
#undef PG8_BAR
#undef PG8_SCHED
}
}

#define LAS __attribute__((address_space(3)))
typedef unsigned short bf16;
typedef short bf16x8 __attribute__((ext_vector_type(8)));
typedef short v4i16_t __attribute__((ext_vector_type(4)));
typedef float f32x4 __attribute__((ext_vector_type(4)));
typedef float f32x2 __attribute__((ext_vector_type(2)));
typedef unsigned u32x4 __attribute__((ext_vector_type(4)));
typedef unsigned u32x2 __attribute__((ext_vector_type(2)));

constexpr int NTX = 16384, NTC = 2048, NTOK = 18432, DM = 1024, FF = 2816;
constexpr int EVW = 2592, EVP = 2816, ODP = 1280;
constexpr float EPS = 1e-6f;
constexpr size_t MiB = 1u << 20;
constexpr size_t WS_MOD = 1 * MiB, WS_WEV = 2 * MiB, WS_WOD = 13 * MiB, WS_WUQ = 18 * MiB, WS_WUKV = 20 * MiB, WS_WMIX = 22 * MiB,
                 WS_WFI = 30 * MiB, WS_WFO = 74 * MiB, WS_SGW = 96 * MiB, WS_DFTC = 96 * MiB + 512 * 1024, WS_DFTX = 97 * MiB, WS_H = 113 * MiB,
                 WS_ZX = 121 * MiB, WS_R1 = 157 * MiB, WS_R2 = 256 * MiB, WS_END = 366 * MiB;
constexpr size_t R1_QA = 0, R1_KVA = 14 * MiB, R1_KPE = 23 * MiB, R1_FBX = 26 * MiB, R1_FBC = 42 * MiB, R1_YQ = 44 * MiB;
constexpr size_t R2_U = 0, R2_DD = 72 * MiB, R2_SB = 73 * MiB, R2_YKV = 0, R2_KK = 54 * MiB;
constexpr int LDS_BYTES = 131072 + 1024;

struct Args { const float* in[27]; float* out; unsigned char* ws; int ph_lo, ph_hi; };

__device__ __forceinline__ unsigned f2bf(float f) { unsigned u = __float_as_uint(f); return (u + 0x7fffu + ((u >> 16) & 1u)) >> 16; }
__device__ __forceinline__ unsigned pk2(float lo, float hi) { unsigned r; asm("v_cvt_pk_bf16_f32 %0, %1, %2" : "=v"(r) : "v"(lo), "v"(hi)); return r; }
__device__ __forceinline__ float bf2f(bf16 h) { return __uint_as_float((unsigned)h << 16); }
__device__ __forceinline__ float bflo(unsigned w) { return __uint_as_float(w << 16); }
__device__ __forceinline__ float bfhi(unsigned w) { return __uint_as_float(w & 0xffff0000u); }
__device__ __forceinline__ float wave_sum(float v) {
#pragma unroll
    for (int o = 1; o < 64; o <<= 1) v += __shfl_xor(v, o);
    return v;
}
__device__ __forceinline__ float silu_f(float x) { return x * __builtin_amdgcn_rcpf(1.f + __expf(-x)); }
__device__ __forceinline__ float gelu_f(float v) {
    const float t = __builtin_amdgcn_rcpf(fabsf(v) * 0.2316418882f + 1.0f);
    float q = t * 0.5307027145f + (-0.7265760135f); q = q * t + 0.7107068705f; q = q * t + (-0.142248368f); q = q * t + 0.127414796f; q = q * t;
    const float m = v * (q * __builtin_amdgcn_exp2f(v * v * (-0.72134752044f)));
    return v < 0.f ? m : v - m;
}
__device__ __forceinline__ float logsig_f(float y) { return fminf(y, 0.f) - __logf(1.f + __expf(-fabsf(y))); }
#define LDS_WAIT() asm volatile("s_waitcnt lgkmcnt(0)" ::: "memory")
__device__ __forceinline__ bf16x8 tr2(const LAS unsigned char* p1, const LAS unsigned char* p2) {
    v4i16_t lo = __builtin_amdgcn_ds_read_tr16_b64_v4i16((LAS v4i16_t*)p1);
    v4i16_t hi = __builtin_amdgcn_ds_read_tr16_b64_v4i16((LAS v4i16_t*)p2);
    return (bf16x8){lo[0], lo[1], lo[2], lo[3], hi[0], hi[1], hi[2], hi[3]};
}
#define MFMA16(a, b, c) __builtin_amdgcn_mfma_f32_16x16x32_bf16((a), (b), (c), 0, 0, 0)

struct EpiStore {
    static constexpr bool PERM = true, AFTER_DRAIN = false;
    bf16* O; int ldc; int ncols;
    __device__ __forceinline__ void operator()(const pg8::f32x4 (&acc)[2][2][4][2], const pg8::Unit& u, int wr, int wc, int fr, int fq) const {
        const int row0 = u.pm * 256 + wr * 64 + fr, col0 = u.pn * 256 + wc * 32 + 8 * fq;
#pragma unroll
        for (int ai = 0; ai < 2; ++ai)
#pragma unroll
            for (int m = 0; m < 4; ++m) { bf16* rowp = O + (size_t)(row0 + ai * 128 + m * 16) * ldc;
#pragma unroll
                for (int bj = 0; bj < 2; ++bj) { const int col = col0 + bj * 128;
                    if (col < ncols) { const pg8::f32x4 v0 = acc[ai][bj][m][0], v1 = acc[ai][bj][m][1]; u32x4 w; w.x = pk2(v0[0], v0[1]); w.y = pk2(v0[2], v0[3]); w.z = pk2(v1[0], v1[1]); w.w = pk2(v1[2], v1[3]);
                        *(u32x4*)(rowp + col) = w; } } }
    }
};
struct EpiOddIn {
    static constexpr bool PERM = true, AFTER_DRAIN = false;
    bf16 *QA, *KVA, *KPE, *FBX, *FBC;
    __device__ __forceinline__ void operator()(const pg8::f32x4 (&acc)[2][2][4][2], const pg8::Unit& u, int wr, int wc, int fr, int fq) const {
        if (u.pn >= 2) {
            const int row0 = u.pm * 256 + wr * 64 + fr, col0 = (u.pn - 2) * 256 + wc * 32 + 8 * fq;
#pragma unroll
            for (int ai = 0; ai < 2; ++ai)
#pragma unroll
                for (int m = 0; m < 4; ++m) { const size_t row = (size_t)(row0 + ai * 128 + m * 16);
#pragma unroll
                    for (int bj = 0; bj < 2; ++bj) { const int col = col0 + bj * 128;
                        if (col < 704) { const pg8::f32x4 v0 = acc[ai][bj][m][0], v1 = acc[ai][bj][m][1]; u32x4 w; w.x = pk2(v0[0], v0[1]); w.y = pk2(v0[2], v0[3]); w.z = pk2(v1[0], v1[1]); w.w = pk2(v1[2], v1[3]);
                            bf16* dst = col < 384 ? QA + row * 384 + col : (col < 640 ? KVA + row * 256 + (col - 384) : KPE + row * 64 + (col - 640));
                            *(u32x4*)dst = w; } } }
        } else {
            bf16* base; int stride, t0;
            if (u.pm < 64) { base = FBX + (size_t)(u.pm >> 3) * 256 * 4096 + u.pn * 2048; stride = 4096; t0 = (u.pm & 7) * 256; }
            else { base = FBC + (size_t)(u.pm - 64) * 256 * 512 + u.pn * 256; stride = 512; t0 = 0; }
#pragma unroll
            for (int ai = 0; ai < 2; ++ai)
#pragma unroll
                for (int m = 0; m < 4; ++m) { const int t = t0 + ai * 128 + wr * 64 + m * 16 + fr;
#pragma unroll
                    for (int bj = 0; bj < 2; ++bj)
#pragma unroll
                        for (int n = 0; n < 2; ++n)
#pragma unroll
                            for (int e = 0; e < 4; ++e) { const int c = bj * 128 + wc * 32 + 8 * fq + 4 * n + e; base[(size_t)c * stride + t] = (bf16)f2bf(acc[ai][bj][m][n][e]); } }
        }
    }
};
struct EpiResid {
    static constexpr bool PERM = true, AFTER_DRAIN = false;
    const float* xb; const float* hb; float* xo; float* ho; const float* gate; bf16* T;
    __device__ __forceinline__ void operator()(const pg8::f32x4 (&acc)[2][2][4][2], const pg8::Unit& u, int wr, int wc, int fr, int fq) const {
        const bool isx = u.pm < 64; const int mr = isx ? (u.pm >> 3) : 8;
        const int rbase = isx ? u.pm * 256 : (u.pm - 64) * 256;
        const float* gp = gate + (size_t)mr * 6144; const int col0 = u.pn * 256 + wc * 32 + 8 * fq;
        if (!isx) { bf16* tp = T + (size_t)u.ks * 2048 * DM;
#pragma unroll
            for (int bj = 0; bj < 2; ++bj) { const int c = col0 + bj * 128; const pg8::f32x4 g0 = *(const pg8::f32x4*)(gp + c), g1 = *(const pg8::f32x4*)(gp + c + 4);
#pragma unroll
                for (int ai = 0; ai < 2; ++ai)
#pragma unroll
                    for (int m = 0; m < 4; ++m) { const size_t off = (size_t)(rbase + ai * 128 + wr * 64 + m * 16 + fr) * DM + c; const pg8::f32x4 v0 = g0 * acc[ai][bj][m][0], v1 = g1 * acc[ai][bj][m][1]; u32x4 w; w.x = pk2(v0[0], v0[1]); w.y = pk2(v0[2], v0[3]); w.z = pk2(v1[0], v1[1]); w.w = pk2(v1[2], v1[3]); *(u32x4*)(tp + off) = w; } }
            return; }
#pragma unroll
        for (int bj = 0; bj < 2; ++bj) { const int c = col0 + bj * 128; const pg8::f32x4 g0 = *(const pg8::f32x4*)(gp + c), g1 = *(const pg8::f32x4*)(gp + c + 4);
#pragma unroll
            for (int ai = 0; ai < 2; ++ai)
#pragma unroll
                for (int m = 0; m < 4; ++m) { const size_t off = (size_t)(rbase + ai * 128 + wr * 64 + m * 16 + fr) * DM + c;
                    const pg8::f32x4 b0 = *(const pg8::f32x4*)(xb + off), b1 = *(const pg8::f32x4*)(xb + off + 4);
                    *(pg8::f32x4*)(xo + off) = b0 + g0 * acc[ai][bj][m][0]; *(pg8::f32x4*)(xo + off + 4) = b1 + g1 * acc[ai][bj][m][1]; } }
    }
};
struct EpiSwiglu {
    static constexpr bool PERM = true, AFTER_DRAIN = false;
    bf16* ACT;
    __device__ __forceinline__ void operator()(const pg8::f32x4 (&acc)[2][2][4][2], const pg8::Unit& u, int wr, int wc, int fr, int fq) const {
        const int row0 = u.pm * 256 + wr * 64 + fr, col = u.pn * 128 + wc * 32 + 8 * fq;
#pragma unroll
        for (int ai = 0; ai < 2; ++ai)
#pragma unroll
            for (int m = 0; m < 4; ++m) { float o[8];
#pragma unroll
                for (int n = 0; n < 2; ++n)
#pragma unroll
                    for (int e = 0; e < 4; ++e) { const float g = acc[ai][0][m][n][e], up = acc[ai][1][m][n][e]; o[4 * n + e] = silu_f(g) * up; }
                u32x4 w; w.x = pk2(o[0], o[1]); w.y = pk2(o[2], o[3]); w.z = pk2(o[4], o[5]); w.w = pk2(o[6], o[7]);
                *(u32x4*)(ACT + (size_t)(row0 + ai * 128 + m * 16) * FF + col) = w; }
    }
};
struct EpiFourier {
    static constexpr bool PERM = true, AFTER_DRAIN = false;
    bf16* MX; int rowbase, rpb; float scale;
    __device__ __forceinline__ void operator()(const pg8::f32x4 (&acc)[2][2][4][2], const pg8::Unit& u, int wr, int wc, int fr, int fq) const {
        const int k0 = u.pm * 256 + wr * 64 + fr, col0 = wc * 32 + 8 * fq;
#pragma unroll
        for (int ai = 0; ai < 2; ++ai)
#pragma unroll
            for (int m = 0; m < 4; ++m) { bf16* rowp = MX + (size_t)(rowbase + u.pn * rpb + k0 + ai * 128 + m * 16) * DM + col0;
#pragma unroll
                for (int bj = 0; bj < 2; ++bj) { const pg8::f32x4 v0 = acc[ai][bj][m][0] * scale, v1 = acc[ai][bj][m][1] * scale; u32x4 w; w.x = pk2(v0[0], v0[1]); w.y = pk2(v0[2], v0[3]); w.z = pk2(v1[0], v1[1]); w.w = pk2(v1[2], v1[3]);
                    *(u32x4*)(rowp + bj * 128) = w; } }
    }
};

#define XB_TMO      128
#define XB_XCNT(j)  (256  + 64 * (j))
#define XB_XSUB(j)  (1280 + 64 * (j))
#define XB_XGEN(j)  (2304 + 64 * (j))
#define XB_TOP      3328
#define XB_TOPGEN   3392
#define XCD_BAR_WORDS 3456
#define XB_SPIN_CAP (1u << 18)

__device__ __forceinline__ unsigned xb_ld(unsigned* p)              { return __hip_atomic_load(p, __ATOMIC_RELAXED, __HIP_MEMORY_SCOPE_AGENT); }
__device__ __forceinline__ unsigned xb_add(unsigned* p, unsigned v) { return __hip_atomic_fetch_add(p, v, __ATOMIC_RELAXED, __HIP_MEMORY_SCOPE_AGENT); }
__device__ __forceinline__ unsigned xb_xcc_id() { return (unsigned)__builtin_amdgcn_s_getreg((3 << 11) | 20) & 0xFu; }
#define XB_SPIN(cond, bar) do { unsigned _sp = 0; while (cond) { __builtin_amdgcn_s_sleep(1); \
    if ((++_sp & 255u) == 0u) { if (xb_ld(&(bar)[XB_TMO])) break; if (_sp > XB_SPIN_CAP) { atomicAdd(&(bar)[XB_TMO], 1u); break; } } } } while (0)

struct XcdBarrier {
    unsigned* bar; unsigned x;
    volatile LAS unsigned* st;
};

__device__ __forceinline__ XcdBarrier xcd_barrier_post(unsigned* bar, volatile LAS unsigned* st) {
    XcdBarrier b; b.bar = bar; b.x = xb_xcc_id(); b.st = st;
    if (threadIdx.x == 0) (void)xb_add(&bar[XB_XCNT(b.x)], 1u);
    return b;
}
__device__ __forceinline__ void xcd_barrier_complete(unsigned* bar, unsigned x, unsigned& nloc, unsigned& nx) {
    const unsigned G = gridDim.x * gridDim.y * gridDim.z;
    unsigned sum, cnt, mine, sp = 0u;
    for (;;) {
        sum = 0u; cnt = 0u; mine = 0u;
#pragma unroll
        for (unsigned j = 0; j < 16; ++j) { const unsigned c = xb_ld(&bar[XB_XCNT(j)]); sum += c; cnt += (c > 0u) ? 1u : 0u; mine = (j == x) ? c : mine; }
        if (sum == G) break;
        __builtin_amdgcn_s_sleep(1);
        if ((++sp & 255u) == 0u) { if (xb_ld(&bar[XB_TMO])) break; if (sp > XB_SPIN_CAP) { atomicAdd(&bar[XB_TMO], 1u); break; } }
    }
    nloc = mine > 0u ? mine : 1u; nx = cnt > 0u ? cnt : 1u;
}

__device__ __forceinline__ void xcd_barrier(const XcdBarrier& b) {
    asm volatile("s_waitcnt vmcnt(0)" ::: "memory");
    __syncthreads();
    if (threadIdx.x == 0) {
        unsigned* bar = b.bar;
        __builtin_amdgcn_s_waitcnt(0);
        unsigned nloc = b.st[0], nx = b.st[1];
        if (nloc == 0u) { xcd_barrier_complete(bar, b.x, nloc, nx); b.st[0] = nloc; b.st[1] = nx; }
        const unsigned old = xb_add(&bar[XB_XSUB(b.x)], 1u);
        const unsigned gen = old / nloc;
        if (old + 1u == (gen + 1u) * nloc) {
            __builtin_amdgcn_fence(__ATOMIC_RELEASE, "agent");
            asm volatile("s_waitcnt vmcnt(0)" ::: "memory");
            const unsigned og = xb_add(&bar[XB_TOP], 1u);
            const unsigned tg = og / nx;
            if (og + 1u == (tg + 1u) * nx) xb_add(&bar[XB_TOPGEN], 1u);
            else XB_SPIN(xb_ld(&bar[XB_TOPGEN]) == tg, bar);
            __builtin_amdgcn_fence(__ATOMIC_ACQUIRE, "agent");
            xb_add(&bar[XB_XGEN(b.x)], 1u);
            asm volatile("s_waitcnt vmcnt(0)" ::: "memory");
        } else {
            XB_SPIN(xb_ld(&bar[XB_XGEN(b.x)]) == gen, bar);
            __builtin_amdgcn_fence(__ATOMIC_ACQUIRE, "agent");
            asm volatile("s_waitcnt vmcnt(0)" ::: "memory");
        }
    }
    __syncthreads();
}

__device__ __forceinline__ const float* ldptr(LAS unsigned char* L, int i) {
    const LAS unsigned* p = (const LAS unsigned*)(L + 131072) + 2 * i;
    const unsigned lo = __builtin_amdgcn_readfirstlane(p[0]), hi = __builtin_amdgcn_readfirstlane(p[1]);
    return (const float*)(((unsigned long long)hi << 32) | (unsigned long long)lo);
}
#define INP(i) ldptr(L, (i))
#define OUTP ((float*)ldptr(L, 27))
#define WSP ((unsigned char*)ldptr(L, 28))
__device__ __forceinline__ void tr_item(const float* W, int ldw, int K, int ncb, bf16* WT, int row_off, int mode, const float* gk, LAS float* scr, int item, int lane) {
    const int kb = item / ncb, nb = item % ncb, k0 = 64 * kb, n0 = 32 * nb;
    { const int kq = lane >> 3, nq = lane & 7; f32x4 v[8];
#pragma unroll
      for (int i = 0; i < 8; ++i) v[i] = *(const f32x4*)(W + (size_t)(k0 + 8 * i + kq) * ldw + n0 + 4 * nq);
#pragma unroll
      for (int i = 0; i < 8; ++i) { const int kk = 8 * i + kq; const float gv = gk ? gk[k0 + kk] : 1.0f; LAS float* d = scr + kk * 33 + 4 * nq; d[0] = v[i].x * gv; d[1] = v[i].y * gv; d[2] = v[i].z * gv; d[3] = v[i].w * gv; } }
    LDS_WAIT();
    const int c = lane & 7;
#pragma unroll
    for (int j = 0; j < 4; ++j) { const int n = (lane >> 3) + 8 * j; const LAS float* s = scr + (8 * c) * 33 + n;
        u32x4 o; o.x = pk2(s[0 * 33], s[1 * 33]); o.y = pk2(s[2 * 33], s[3 * 33]); o.z = pk2(s[4 * 33], s[5 * 33]); o.w = pk2(s[6 * 33], s[7 * 33]);
        const int nn = n0 + n; int dr = nn;
        if (mode == 1) dr = nn < FF ? ((nn >> 7) * 256 + (nn & 127)) : ((((nn - FF) >> 7) * 256) + 128 + ((nn - FF) & 127));
        *(u32x4*)(WT + (size_t)(row_off + dr) * K + k0 + 8 * c) = o; }
    LDS_WAIT();
}

__device__ __forceinline__ void prologue(LAS unsigned char* L, int tid, int wave, int lane) {
    unsigned char* ws = WSP;
    LAS float* tab = (LAS float*)L;
    LAS float* sv = (LAS float*)(L + 8192);
    LAS float* red = (LAS float*)(L + 45056);
    const int G = gridDim.x, bid = blockIdx.x;
    const size_t gtid_all = (size_t)bid * 512 + tid, NT_all = (size_t)G * 512;
    LAS float* c64 = (LAS float*)(L + 81920); LAS float* s64 = c64 + 64;
    for (int i = tid; i < 2048; i += 512) tab[i] = cospif((float)i * (1.0f / 1024.0f));
    if (tid < 64) { c64[tid] = cospif((float)tid * (1.0f / 32.0f)); s64[tid] = -sinpif((float)tid * (1.0f / 32.0f)); }
    for (int i = tid; i < 9216; i += 512) { const int r = i >> 10, k = i & 1023; const float v = r < 8 ? INP(1)[r * 1024 + k] : INP(3)[k]; sv[i] = silu_f(v); }
    __syncthreads();
    float* MOD = (float*)(ws + WS_MOD);
    for (int it = bid; it < 256; it += G) {
        const int l = it >> 6, col0 = (it & 63) * 96, col = col0 + 2 * (lane < 48 ? lane : 0);
        const float* wp = INP(4) + ((size_t)l * 1024 + wave * 128) * 6144 + col;
        float acc[9][2];
#pragma unroll
        for (int r = 0; r < 9; ++r) { acc[r][0] = 0.f; acc[r][1] = 0.f; }
#pragma unroll 8
        for (int k = 0; k < 128; ++k) { const f32x2 w = *(const f32x2*)(wp + (size_t)k * 6144);
#pragma unroll
            for (int r = 0; r < 9; ++r) { const float s = sv[r * 1024 + wave * 128 + k]; acc[r][0] += s * w.x; acc[r][1] += s * w.y; } }
#pragma unroll
        for (int r = 0; r < 9; ++r) { red[(wave * 9 + r) * 128 + 2 * lane] = acc[r][0]; red[(wave * 9 + r) * 128 + 2 * lane + 1] = acc[r][1]; }
        __syncthreads();
        for (int i = tid; i < 864; i += 512) { const int r = i / 96, cc = i % 96; float s = 0.f;
#pragma unroll
            for (int w = 0; w < 8; ++w) s += red[(w * 9 + r) * 128 + cc];
            MOD[((size_t)l * 9 + r) * 6144 + col0 + cc] = s + INP(5)[l * 6144 + col0 + cc]; }
        __syncthreads();
    }
    bf16* WOD = (bf16*)(ws + WS_WOD);
    const bool cvt_all = true; const size_t gtid = cvt_all ? gtid_all : (bid >= 192 ? (size_t)(bid - 192) * 512 + tid : (size_t)1 << 40); const size_t NT = cvt_all ? NT_all : (size_t)(G - 192) * 512;
    for (size_t idx = gtid; idx < (size_t)2 * 512 * 1024; idx += NT) {
        const int m = (int)idx & 63, kk = ((int)idx >> 6) & 1023, rest = (int)(idx >> 16), g = rest & 3, part = (rest >> 2) & 1, i = rest >> 3;
        const float* src = INP(20) + ((size_t)i * 1024 + kk) * 960 + g * 64; float acc = 0.f;
        const LAS float* tw64 = part ? s64 : c64;
        for (int c = 0; c < 64; ++c) { const int j = (m * c) & 63; acc += tw64[j] * src[c]; }
        WOD[((size_t)i * ODP + part * 256 + g * 64 + m) * 1024 + kk] = (bf16)f2bf(acc);
    }
    { bf16* SGW = (bf16*)(ws + WS_SGW); for (size_t idx = gtid; idx < 131072; idx += NT) SGW[idx] = (bf16)f2bf(INP(18)[idx]); }
    { bf16* DX = (bf16*)(ws + WS_DFTX);
      for (size_t idx = gtid; idx < (size_t)2048 * 512; idx += NT) { const int k = (int)(idx >> 9), t8 = ((int)idx & 511) * 8; float v[8];
#pragma unroll
          for (int e = 0; e < 8; ++e) { const int tp = t8 + e; v[e] = tp < 2048 ? tab[(k * tp) & 2047] : tab[(k * (tp - 2048) - 512) & 2047]; }
          u32x4 o; o.x = pk2(v[0], v[1]); o.y = pk2(v[2], v[3]); o.z = pk2(v[4], v[5]); o.w = pk2(v[6], v[7]); *(u32x4*)(DX + (size_t)k * 4096 + t8) = o; } }
    { bf16* DC = (bf16*)(ws + WS_DFTC);
      for (size_t idx = gtid; idx < (size_t)256 * 64; idx += NT) { const int k = (int)(idx >> 6), t8 = ((int)idx & 63) * 8; float v[8];
#pragma unroll
          for (int e = 0; e < 8; ++e) { const int tp = t8 + e; v[e] = tp < 256 ? tab[((k * tp) & 255) * 8] : tab[(((k * (tp - 256)) & 255) * 8 - 512) & 2047]; }
          u32x4 o; o.x = pk2(v[0], v[1]); o.y = pk2(v[2], v[3]); o.z = pk2(v[4], v[5]); o.w = pk2(v[6], v[7]); *(u32x4*)(DC + (size_t)k * 512 + t8) = o; } }
    { const u32x4 z = {0u, 0u, 0u, 0u};
      for (size_t idx = gtid; idx < (size_t)2 * 28672; idx += NT) { const int i = (int)(idx / 28672), r = (int)(idx % 28672); *(u32x4*)((bf16*)(ws + WS_WEV) + ((size_t)i * EVP + EVW) * 1024 + (size_t)r * 8) = z; }
      for (size_t idx = gtid; idx < (size_t)2 * 8192; idx += NT) { const int i = (int)(idx / 8192), r = (int)(idx % 8192); *(u32x4*)(WOD + ((size_t)i * ODP + 1216) * 1024 + (size_t)r * 8) = z; }
      for (size_t idx = gtid; idx < (size_t)2 * 6144; idx += NT) { const int i = (int)(idx / 6144), r = (int)(idx % 6144); *(u32x4*)((bf16*)(ws + WS_WUQ) + ((size_t)i * 1280 + 1152) * 384 + (size_t)r * 8) = z; } }
    __syncthreads();
    LAS float* scr = (LAS float*)(L + 45056 + wave * 8448);
    const int gw = bid * 8 + wave, NGW = G * 8;
    constexpr int I_EV = 16 * 81, I_OD = 16 * 22, I_UQ = 6 * 36, I_UKV = 4 * 48, I_MIX = 16 * 32, I_FI = 16 * 176, I_FO = 44 * 32;
    constexpr int NITEMS = 2 * (I_EV + I_OD + I_UQ + I_UKV) + 4 * (I_MIX + I_FI + I_FO);
    for (int it = gw; it < NITEMS; it += NGW) {
        int r = it;
        if (r < 4 * I_FI) { const int l = r / I_FI; tr_item(INP(9) + (size_t)l * 1024 * 5632, 5632, 1024, 176, (bf16*)(ws + WS_WFI) + (size_t)l * 5632 * 1024, 0, 1, nullptr, scr, r % I_FI, lane); continue; } r -= 4 * I_FI;
        if (r < 4 * I_FO) { const int l = r / I_FO; tr_item(INP(10) + (size_t)l * 2816 * 1024, 1024, 2816, 32, (bf16*)(ws + WS_WFO) + (size_t)l * 1024 * 2816, 0, 0, nullptr, scr, r % I_FO, lane); continue; } r -= 4 * I_FO;
        if (r < 4 * I_MIX) { const int l = r / I_MIX; tr_item(INP(8) + (size_t)l * 1024 * 1024, 1024, 1024, 32, (bf16*)(ws + WS_WMIX) + (size_t)l * 1024 * 1024, 0, 0, nullptr, scr, r % I_MIX, lane); continue; } r -= 4 * I_MIX;
        if (r < 2 * I_EV) { const int i = r / I_EV; tr_item(INP(11) + (size_t)i * 1024 * EVW, EVW, 1024, 81, (bf16*)(ws + WS_WEV) + (size_t)i * EVP * 1024, 0, 0, nullptr, scr, r % I_EV, lane); continue; } r -= 2 * I_EV;
        if (r < 2 * I_OD) { const int i = r / I_OD; tr_item(INP(20) + (size_t)i * 1024 * 960 + 256, 960, 1024, 22, WOD + (size_t)i * ODP * 1024, 512, 0, nullptr, scr, r % I_OD, lane); continue; } r -= 2 * I_OD;
        if (r < 2 * I_UQ) { const int i = r / I_UQ; tr_item(INP(22) + (size_t)i * 384 * 1152, 1152, 384, 36, (bf16*)(ws + WS_WUQ) + (size_t)i * 1280 * 384, 0, 0, INP(21) + i * 384, scr, r % I_UQ, lane); continue; } r -= 2 * I_UQ;
        { const int i = r / I_UKV; tr_item(INP(24) + (size_t)i * 256 * 1536, 1536, 256, 48, (bf16*)(ws + WS_WUKV) + (size_t)i * 1536 * 256, 0, 0, INP(23) + i * 256, scr, r % I_UKV, lane); }
    }
}

__device__ __forceinline__ void norm_phase(const float* xin, const float* hin, const float* gvec, const float* mod, int shift_idx, int scale_idx, bf16* Z, int ntok, int wave, int lane, const bf16* T, float* hout) {
    constexpr int NR = 3;
    const int gw = blockIdx.x * 8 + wave, NGW = gridDim.x * 8;
    f32x4 gg[4];
#pragma unroll
    for (int j = 0; j < 4; ++j) gg[j] = *(const f32x4*)(gvec + 4 * lane + 256 * j);
    for (int rb = gw; rb < ntok; rb += NR * NGW) {
        f32x4 v[NR][4];
#pragma unroll
        for (int q = 0; q < NR; ++q) { const int row = (rb + q * NGW < ntok) ? rb + q * NGW : rb; const float* src = row < NTX ? xin + (size_t)row * DM : hin + (size_t)(row - NTX) * DM;
#pragma unroll
            for (int j = 0; j < 4; ++j) v[q][j] = *(const f32x4*)(src + 4 * lane + 256 * j); }
        if (T && rb + (NR - 1) * NGW >= NTX) {
#pragma unroll
            for (int q = 0; q < NR; ++q) { const int row = rb + q * NGW; if (row >= NTX && row < ntok) {
#pragma unroll
                for (int sp = 0; sp < 8; ++sp)
#pragma unroll
                    for (int j = 0; j < 4; ++j) { const u32x2 w = *(const u32x2*)(T + ((size_t)sp * 2048 + (row - NTX)) * DM + 4 * lane + 256 * j); v[q][j] += (f32x4){bflo(w.x), bfhi(w.x), bflo(w.y), bfhi(w.y)}; }
#pragma unroll
                for (int j = 0; j < 4; ++j) *(f32x4*)(hout + (size_t)(row - NTX) * DM + 4 * lane + 256 * j) = v[q][j]; } }
        }
        float ss[NR];
#pragma unroll
        for (int q = 0; q < NR; ++q) { float s = 0.f;
#pragma unroll
            for (int j = 0; j < 4; ++j) s += (v[q][j].x * v[q][j].x + v[q][j].y * v[q][j].y) + (v[q][j].z * v[q][j].z + v[q][j].w * v[q][j].w);
            ss[q] = s; }
#pragma unroll
        for (int o = 1; o < 64; o <<= 1)
#pragma unroll
            for (int q = 0; q < NR; ++q) ss[q] += __shfl_xor(ss[q], o);
#pragma unroll
        for (int q = 0; q < NR; ++q) { const int row = rb + q * NGW; if (row < ntok) {
            const float rstd = rsqrtf(ss[q] * (1.f / DM) + EPS); const int mr = row < NTX ? (row >> 11) : 8; const float* mp = mod + (size_t)mr * 6144;
#pragma unroll
            for (int j = 0; j < 4; ++j) { const int c = 4 * lane + 256 * j; const f32x4 sc = *(const f32x4*)(mp + scale_idx * 1024 + c), sh = *(const f32x4*)(mp + shift_idx * 1024 + c);
                const f32x4 z = v[q][j] * rstd * gg[j] * (sc + 1.0f) + sh; u32x2 o; o.x = pk2(z.x, z.y); o.y = pk2(z.z, z.w); *(u32x2*)(Z + (size_t)row * DM + c) = o; } } }
    }
}

__device__ __forceinline__ int gla_tok0(int b, int c) { return c < 4 ? NTX + b * 256 + 64 * c : b * 2048 + 64 * (c - 4); }
__device__ __forceinline__ int gla_uidx(int dir, int b, int h, int c) { return ((dir * 8 + b) * 4 + h) * 36 + c; }
__device__ __forceinline__ void gla_gates(const LAS bf16* A32, const float (&wf)[16], const float (&wb)[16], float bf0, float bb0, LAS float* Gf, LAS float* Gb, LAS float* TOT, int tid) {
    const int k = tid & 63;
#pragma unroll 2
    for (int i = 0; i < 8; ++i) { const int p = (tid >> 6) + 8 * i; const LAS u32x4* ap = (const LAS u32x4*)(A32 + p * 32);
        const u32x4 a0 = ap[0], a1 = ap[1], b0 = ap[2], b1 = ap[3];
        float yf = bf0, yb = bb0;
#pragma unroll
        for (int w = 0; w < 4; ++w) { yf += bflo(a0[w]) * wf[2 * w] + bfhi(a0[w]) * wf[2 * w + 1]; yf += bflo(a1[w]) * wf[8 + 2 * w] + bfhi(a1[w]) * wf[9 + 2 * w];
                                      yb += bflo(b0[w]) * wb[2 * w] + bfhi(b0[w]) * wb[2 * w + 1]; yb += bflo(b1[w]) * wb[8 + 2 * w] + bfhi(b1[w]) * wb[9 + 2 * w]; }
        Gf[p * 64 + k] = logsig_f(yf) * 0.0625f; Gb[p * 64 + k] = logsig_f(yb) * 0.0625f; }
    __syncthreads();
    {
        const int dir = tid >> 8, seg = (tid >> 6) & 3; LAS float* arr = dir ? Gb : Gf; float a[16];
#pragma unroll
        for (int j = 0; j < 16; ++j) a[j] = arr[(16 * seg + j) * 64 + k];
        if (!dir) {
#pragma unroll
            for (int j = 1; j < 16; ++j) a[j] += a[j - 1];
            TOT[(dir * 4 + seg) * 64 + k] = a[15]; }
        else {
#pragma unroll
            for (int j = 14; j >= 0; --j) a[j] += a[j + 1];
            TOT[(dir * 4 + seg) * 64 + k] = a[0]; }
        __syncthreads();
        float off = 0.f;
#pragma unroll
        for (int s2 = 0; s2 < 4; ++s2) { const float t = TOT[(dir * 4 + s2) * 64 + k]; if (dir ? (s2 > seg) : (s2 < seg)) off += t; }
#pragma unroll
        for (int j = 0; j < 16; ++j) arr[(16 * seg + j) * 64 + k] = a[j] + off;
    }
    __syncthreads();
}
__device__ __forceinline__ void gla_passA(int unit, const bf16* P, const float* waf, const float* baf, const float* wab, const float* bab, bf16* U, float* DD, LAS unsigned char* L, int tid, int wave, int lane) {
    const int b = unit / 144, rem = unit % 144, h = rem / 36, c = rem % 36, tok0 = gla_tok0(b, c);
    LAS float* Gf = (LAS float*)L; LAS float* Gb = (LAS float*)(L + 16384);
    LAS bf16* KDf = (LAS bf16*)(L + 32768); LAS bf16* KDb = (LAS bf16*)(L + 32768 + 9216); LAS bf16* Vs = (LAS bf16*)(L + 32768 + 18432); LAS bf16* A32 = (LAS bf16*)(L + 32768 + 18432 + 18432);
    const int k = tid & 63, rpos = tid >> 3, rk8 = (tid & 7) * 8;
    u32x4 a32 = {0u, 0u, 0u, 0u}; if (tid < 256) a32 = *(const u32x4*)(P + (size_t)(tok0 + (tid >> 2)) * EVW + 1536 + (tid & 3) * 8);
    float wf[16], wb[16];
#pragma unroll
    for (int r = 0; r < 16; ++r) { wf[r] = waf[r * 256 + h * 64 + k]; wb[r] = wab[r * 256 + h * 64 + k]; }
    const float bf0 = baf[h * 64 + k], bb0 = bab[h * 64 + k];
    const u32x4 kraw = *(const u32x4*)(P + (size_t)(tok0 + rpos) * EVW + 256 + h * 64 + rk8);
    u32x4 vraw[2];
#pragma unroll
    for (int i = 0; i < 2; ++i) { const int q = tid + 512 * i; vraw[i] = *(const u32x4*)(P + (size_t)(tok0 + (q >> 4)) * EVW + 512 + h * 128 + (q & 15) * 8); }
    if (tid < 256) *(LAS u32x4*)(A32 + (tid >> 2) * 32 + (tid & 3) * 8) = a32;
#pragma unroll
    for (int i = 0; i < 2; ++i) { const int q = tid + 512 * i; *(LAS u32x4*)(Vs + (q >> 4) * 144 + (q & 15) * 8) = vraw[i]; }
    __syncthreads();
    gla_gates(A32, wf, wb, bf0, bb0, Gf, Gb, (LAS float*)((LAS unsigned char*)A32 + 4096), tid);
    {
        float kv[8];
#pragma unroll
        for (int w = 0; w < 4; ++w) { kv[2 * w] = bflo(kraw[w]); kv[2 * w + 1] = bfhi(kraw[w]); }
        u32x4 of, ob;
#pragma unroll
        for (int w = 0; w < 4; ++w) { const int k0 = rk8 + 2 * w;
            const float f0 = kv[2 * w] * __expf(Gf[63 * 64 + k0] - Gf[rpos * 64 + k0]), f1 = kv[2 * w + 1] * __expf(Gf[63 * 64 + k0 + 1] - Gf[rpos * 64 + k0 + 1]);
            const float g0 = kv[2 * w] * __expf(Gb[k0] - Gb[rpos * 64 + k0]), g1 = kv[2 * w + 1] * __expf(Gb[k0 + 1] - Gb[rpos * 64 + k0 + 1]);
            of[w] = pk2(f0, f1); ob[w] = pk2(g0, g1); }
        *(LAS u32x4*)(KDf + rpos * 72 + rk8) = of; *(LAS u32x4*)(KDb + rpos * 72 + rk8) = ob;
    }
    if (tid < 64) DD[(size_t)gla_uidx(0, b, h, c) * 64 + tid] = __expf(Gf[63 * 64 + tid]);
    else if (tid < 128) DD[(size_t)gla_uidx(1, b, h, c) * 64 + (tid - 64)] = __expf(Gb[tid - 64]);
    __syncthreads();
    const int g = lane >> 4, i15 = lane & 15, q4 = i15 >> 2, pp = i15 & 3, dv0 = 16 * wave;
    bf16x8 Af[2];
#pragma unroll
    for (int ks = 0; ks < 2; ++ks) { const LAS unsigned char* p1 = (const LAS unsigned char*)Vs + (32 * ks + 8 * g + q4) * 288 + (dv0 + 4 * pp) * 2; Af[ks] = tr2(p1, p1 + 4 * 288); }
#pragma unroll
    for (int dir = 0; dir < 2; ++dir) { const LAS unsigned char* KD = (const LAS unsigned char*)(dir ? KDb : KDf); bf16* up = U + (size_t)gla_uidx(dir, b, h, c) * 8192;
#pragma unroll
        for (int kt = 0; kt < 4; ++kt) { f32x4 acc = {0.f, 0.f, 0.f, 0.f};
#pragma unroll
            for (int ks = 0; ks < 2; ++ks) { const LAS unsigned char* p1 = KD + (32 * ks + 8 * g + q4) * 144 + (16 * kt + 4 * pp) * 2; const bf16x8 Bf = tr2(p1, p1 + 4 * 144); acc = MFMA16(Af[ks], Bf, acc); }
#pragma unroll
            for (int r = 0; r < 4; ++r) up[(dv0 + 4 * g + r) * 64 + 16 * kt + i15] = (bf16)f2bf(acc[r]); } }
    __syncthreads();
}
__device__ __forceinline__ void gla_passB(const bf16* U, const float* DD, bf16* SB, int tid) {
    const size_t NT = (size_t)gridDim.x * 512;
    for (size_t gid = (size_t)blockIdx.x * 512 + tid; gid < (size_t)64 * 2048; gid += NT) {
        const int e4 = (int)gid & 2047, seq = (int)(gid >> 11), dir = seq >> 5, bh = seq & 31, kq = (e4 * 4) & 63;
        f32x4 S = {0.f, 0.f, 0.f, 0.f};
        for (int s0 = 0; s0 < 36; s0 += 6) { f32x4 dd[6], uu[6]; size_t ui[6];
#pragma unroll
            for (int j = 0; j < 6; ++j) { const int step = s0 + j, c = dir ? (step < 4 ? 3 - step : 39 - step) : step; ui[j] = (size_t)(dir * 32 + bh) * 36 + c;
                dd[j] = *(const f32x4*)(DD + ui[j] * 64 + kq); { const u32x2 w = *(const u32x2*)(U + ui[j] * 8192 + (size_t)e4 * 4); uu[j] = (f32x4){bflo(w.x), bfhi(w.x), bflo(w.y), bfhi(w.y)}; } }
#pragma unroll
            for (int j = 0; j < 6; ++j) { u32x2 o; o.x = pk2(S.x, S.y); o.y = pk2(S.z, S.w); *(u32x2*)(SB + ui[j] * 8192 + (size_t)e4 * 4) = o; S = dd[j] * S + uu[j]; } }
    }
}
__device__ __forceinline__ void gla_passC(int unit, const bf16* P, const float* waf, const float* baf, const float* wab, const float* bab, const bf16* SB, const float* onorm, bf16* MX, LAS unsigned char* L, int tid, int wave, int lane) {
    const int b = unit / 144, rem = unit % 144, h = rem / 36, c = rem % 36, tok0 = gla_tok0(b, c);
    LAS float* Gf = (LAS float*)L; LAS float* Gb = (LAS float*)(L + 16384); LAS float* Os = (LAS float*)L;
    LAS bf16* QF = (LAS bf16*)(L + 32768); LAS bf16* KF = (LAS bf16*)(L + 32768 + 9216); LAS bf16* QB = (LAS bf16*)(L + 32768 + 2 * 9216); LAS bf16* KB = (LAS bf16*)(L + 32768 + 3 * 9216);
    LAS bf16* Vs = (LAS bf16*)(L + 69632); LAS bf16* AS = (LAS bf16*)(L + 88064); LAS bf16* A32 = (LAS bf16*)(L + 98304);
    const int k = tid & 63, rpos = tid >> 3, rk8 = (tid & 7) * 8;
    const int g = lane >> 4, i15 = lane & 15, q4 = i15 >> 2, pp = i15 & 3, t0 = 16 * (wave & 3), dvb = 64 * (wave >> 2);
    u32x4 a32 = {0u, 0u, 0u, 0u}; if (tid < 256) a32 = *(const u32x4*)(P + (size_t)(tok0 + (tid >> 2)) * EVW + 1536 + (tid & 3) * 8);
    float wf[16], wb[16];
#pragma unroll
    for (int r = 0; r < 16; ++r) { wf[r] = waf[r * 256 + h * 64 + k]; wb[r] = wab[r * 256 + h * 64 + k]; }
    const float bf0 = baf[h * 64 + k], bb0 = bab[h * 64 + k];
    const u32x4 qraw = *(const u32x4*)(P + (size_t)(tok0 + rpos) * EVW + h * 64 + rk8), kraw = *(const u32x4*)(P + (size_t)(tok0 + rpos) * EVW + 256 + h * 64 + rk8);
    u32x4 vraw[2];
#pragma unroll
    for (int i = 0; i < 2; ++i) { const int q = tid + 512 * i; vraw[i] = *(const u32x4*)(P + (size_t)(tok0 + (q >> 4)) * EVW + 512 + h * 128 + (q & 15) * 8); }
    const bf16* gp = P + (size_t)(tok0 + rpos) * EVW + 1024 + h * 128 + (tid & 7) * 16; const u32x4 g0 = *(const u32x4*)gp, g1 = *(const u32x4*)(gp + 8);
    const bf16* sbf = SB + (size_t)gla_uidx(0, b, h, c) * 8192; const bf16* sbb = SB + (size_t)gla_uidx(1, b, h, c) * 8192;
    bf16x8 Bsf[4][2], Bsb[4][2];
#pragma unroll
    for (int dt = 0; dt < 4; ++dt)
#pragma unroll
        for (int ks = 0; ks < 2; ++ks) { Bsf[dt][ks] = *(const bf16x8*)(sbf + (dvb + 16 * dt + i15) * 64 + 32 * ks + 8 * g); Bsb[dt][ks] = *(const bf16x8*)(sbb + (dvb + 16 * dt + i15) * 64 + 32 * ks + 8 * g); }
    if (tid < 256) *(LAS u32x4*)(A32 + (tid >> 2) * 32 + (tid & 3) * 8) = a32;
#pragma unroll
    for (int i = 0; i < 2; ++i) { const int q = tid + 512 * i; *(LAS u32x4*)(Vs + (q >> 4) * 144 + (q & 15) * 8) = vraw[i]; }
    __syncthreads();
    gla_gates(A32, wf, wb, bf0, bb0, Gf, Gb, (LAS float*)((LAS unsigned char*)A32 + 4096), tid);
    {
        u32x4 oqf, okf, oqb, okb;
#pragma unroll
        for (int w = 0; w < 4; ++w) { const int k0 = rk8 + 2 * w;
            const float q0 = bflo(qraw[w]) * 0.125f, q1 = bfhi(qraw[w]) * 0.125f, k0v = bflo(kraw[w]), k1v = bfhi(kraw[w]);
            const float gf0 = Gf[rpos * 64 + k0], gf1 = Gf[rpos * 64 + k0 + 1], gb0 = Gb[rpos * 64 + k0], gb1 = Gb[rpos * 64 + k0 + 1];
            oqf[w] = pk2(q0 * __expf(gf0), q1 * __expf(gf1)); okf[w] = pk2(k0v * __expf(-gf0), k1v * __expf(-gf1));
            oqb[w] = pk2(q0 * __expf(gb0), q1 * __expf(gb1)); okb[w] = pk2(k0v * __expf(-gb0), k1v * __expf(-gb1)); }
        *(LAS u32x4*)(QF + rpos * 72 + rk8) = oqf; *(LAS u32x4*)(KF + rpos * 72 + rk8) = okf; *(LAS u32x4*)(QB + rpos * 72 + rk8) = oqb; *(LAS u32x4*)(KB + rpos * 72 + rk8) = okb;
    }
    __syncthreads();
    {
        const int sb = 32 * (wave >> 2);
        bf16x8 Aqf[2], Aqb[2];
#pragma unroll
        for (int ks = 0; ks < 2; ++ks) { Aqf[ks] = *(const LAS bf16x8*)(QF + (t0 + i15) * 72 + 32 * ks + 8 * g); Aqb[ks] = *(const LAS bf16x8*)(QB + (t0 + i15) * 72 + 32 * ks + 8 * g); }
#pragma unroll
        for (int st = 0; st < 2; ++st) { const int s0 = sb + 16 * st; f32x4 af = {0.f, 0.f, 0.f, 0.f}, ab = {0.f, 0.f, 0.f, 0.f};
#pragma unroll
            for (int ks = 0; ks < 2; ++ks) { const bf16x8 Bf = *(const LAS bf16x8*)(KF + (s0 + i15) * 72 + 32 * ks + 8 * g), Bb = *(const LAS bf16x8*)(KB + (s0 + i15) * 72 + 32 * ks + 8 * g);
                af = MFMA16(Aqf[ks], Bf, af); ab = MFMA16(Aqb[ks], Bb, ab); }
#pragma unroll
            for (int r = 0; r < 4; ++r) { const int t = t0 + 4 * g + r, s = s0 + i15; const float v = (s <= t ? af[r] : 0.f) + (s >= t ? ab[r] : 0.f); AS[t * 72 + s] = (bf16)f2bf(v); } }
    }
    __syncthreads();
    {
        bf16x8 Aa[2], Aqf[2], Aqb[2];
#pragma unroll
        for (int ks = 0; ks < 2; ++ks) { Aa[ks] = *(const LAS bf16x8*)(AS + (t0 + i15) * 72 + 32 * ks + 8 * g); Aqf[ks] = *(const LAS bf16x8*)(QF + (t0 + i15) * 72 + 32 * ks + 8 * g); Aqb[ks] = *(const LAS bf16x8*)(QB + (t0 + i15) * 72 + 32 * ks + 8 * g); }
#pragma unroll
        for (int dt = 0; dt < 4; ++dt) { const int dv0 = dvb + 16 * dt; f32x4 acc = {0.f, 0.f, 0.f, 0.f};
#pragma unroll
            for (int ks = 0; ks < 2; ++ks) { const LAS unsigned char* p1 = (const LAS unsigned char*)Vs + (32 * ks + 8 * g + q4) * 288 + (dv0 + 4 * pp) * 2; const bf16x8 Bv = tr2(p1, p1 + 4 * 288); acc = MFMA16(Aa[ks], Bv, acc);
                acc = MFMA16(Aqf[ks], Bsf[dt][ks], acc); acc = MFMA16(Aqb[ks], Bsb[dt][ks], acc); }
#pragma unroll
            for (int r = 0; r < 4; ++r) Os[(t0 + 4 * g + r) * 128 + dv0 + i15] = acc[r]; }
    }
    __syncthreads();
    {
        const int t = rpos, d0 = (tid & 7) * 16; float o[16]; float ss = 0.f;
#pragma unroll
        for (int j = 0; j < 16; ++j) { o[j] = Os[t * 128 + d0 + j]; ss += o[j] * o[j]; }
        ss += __shfl_xor(ss, 1); ss += __shfl_xor(ss, 2); ss += __shfl_xor(ss, 4);
        const float r = rsqrtf(ss * (1.f / 128.f) + EPS);
        float gv[16];
#pragma unroll
        for (int w = 0; w < 4; ++w) { gv[2 * w] = bflo(g0[w]); gv[2 * w + 1] = bfhi(g0[w]); gv[8 + 2 * w] = bflo(g1[w]); gv[9 + 2 * w] = bfhi(g1[w]); }
#pragma unroll
        for (int j = 0; j < 16; ++j) o[j] = o[j] * r * onorm[d0 + j] * silu_f(gv[j]);
        u32x4 w0, w1; w0.x = pk2(o[0], o[1]); w0.y = pk2(o[2], o[3]); w0.z = pk2(o[4], o[5]); w0.w = pk2(o[6], o[7]); w1.x = pk2(o[8], o[9]); w1.y = pk2(o[10], o[11]); w1.z = pk2(o[12], o[13]); w1.w = pk2(o[14], o[15]);
        bf16* dst = MX + (size_t)(tok0 + t) * DM + h * 128 + d0; *(u32x4*)dst = w0; *(u32x4*)(dst + 8) = w1;
    }
    __syncthreads();
}

__device__ __forceinline__ void sg_unit(int unit, const bf16* P, const float* vng, const bf16* SGW, const float* bs, bf16* MX, LAS unsigned char* L, int tid, int wave, int lane) {
    const int g4 = unit & 3; int tok0;
    if (unit < 512) { const int b = unit >> 6, j = (unit >> 2) & 15; tok0 = b * 2048 + 128 * j; } else { const int u2 = unit - 512, b = u2 >> 3, j = (u2 >> 2) & 1; tok0 = NTX + b * 256 + 128 * j; }
    LAS bf16* VN = (LAS bf16*)L;
    const int g = lane >> 4, i15 = lane & 15, q4 = i15 >> 2, pp = i15 & 3, t0 = 16 * wave;
    bf16x8 Aw[4];
#pragma unroll
    for (int ks = 0; ks < 4; ++ks) Aw[ks] = *(const bf16x8*)(SGW + ((size_t)g4 * 128 + t0 + i15) * 128 + 32 * ks + 8 * g);
    float bsv[4];
#pragma unroll
    for (int r = 0; r < 4; ++r) bsv[r] = bs[g4 * 128 + t0 + 4 * g + r];
    bf16 uraw[8][4];
    { const int g_ = lane >> 4, i15_ = lane & 15;
#pragma unroll
      for (int ct = 0; ct < 8; ++ct)
#pragma unroll
        for (int r = 0; r < 4; ++r) uraw[ct][r] = P[(size_t)(tok0 + 16 * wave + 4 * g_ + r) * EVW + 1568 + g4 * 128 + 16 * ct + i15_]; }
    {   const int pos = tid >> 2, part = tid & 3; const bf16* sp = P + (size_t)(tok0 + pos) * EVW + 2080 + g4 * 128 + part * 32;
        float x[32]; float ss = 0.f;
#pragma unroll
        for (int q = 0; q < 4; ++q) { const u32x4 w = *(const u32x4*)(sp + 8 * q);
#pragma unroll
            for (int e = 0; e < 4; ++e) { const float a0 = gelu_f(bflo(w[e])), a1 = gelu_f(bfhi(w[e])); x[8 * q + 2 * e] = a0; x[8 * q + 2 * e + 1] = a1; ss += a0 * a0 + a1 * a1; } }
        ss += __shfl_xor(ss, 1); ss += __shfl_xor(ss, 2);
        const float r = rsqrtf(ss * (1.f / 128.f) + EPS); const float* gp = vng + g4 * 128 + part * 32;
#pragma unroll
        for (int q = 0; q < 4; ++q) { u32x4 w;
#pragma unroll
            for (int e = 0; e < 4; ++e) w[e] = pk2(x[8 * q + 2 * e] * r * gp[8 * q + 2 * e], x[8 * q + 2 * e + 1] * r * gp[8 * q + 2 * e + 1]);
            *(LAS u32x4*)(VN + pos * 144 + part * 32 + 8 * q) = w; }
    }
    __syncthreads();
#pragma unroll
    for (int ct = 0; ct < 8; ++ct) { f32x4 acc = {0.f, 0.f, 0.f, 0.f};
#pragma unroll
        for (int ks = 0; ks < 4; ++ks) { const LAS unsigned char* p1 = (const LAS unsigned char*)VN + (32 * ks + 8 * g + q4) * 288 + (16 * ct + 4 * pp) * 2; const bf16x8 Bf = tr2(p1, p1 + 4 * 288); acc = MFMA16(Aw[ks], Bf, acc); }
#pragma unroll
        for (int r = 0; r < 4; ++r) { const size_t tok = (size_t)(tok0 + t0 + 4 * g + r); const int cc = g4 * 128 + 16 * ct + i15;
            const float uv = bf2f(uraw[ct][r]); MX[tok * DM + 512 + cc] = (bf16)f2bf(gelu_f(uv) * (acc[r] + bsv[r])); } }
    __syncthreads();
}

__device__ __forceinline__ void mla_finalize(const bf16* QA, const bf16* KVA, const bf16* KPE, bf16* YQ, bf16* YKV, bf16* KK, const float* qn_g, const float* kn_g, int wave, int lane) {
    const int gw = blockIdx.x * 8 + wave, NGW = gridDim.x * 8;
    const float qg0 = qn_g[lane], qg1 = qn_g[64 + lane], qg2 = qn_g[128 + lane], kg0 = kn_g[lane], kg1 = kn_g[64 + lane], kg2 = kn_g[128 + lane];
    const int half = (lane >> 4) & 1; const float invf = exp2f(-(float)(lane & 15) * (13.287712379549449f / 16.0f));
    for (int tok = gw; tok < NTOK; tok += NGW) {
        bf16* qp = YQ + (size_t)tok * 1152; bf16* kvp = YKV + (size_t)tok * 1536; bf16* kp = KK + (size_t)tok * 1152;
        unsigned wq[3], wk[2];
#pragma unroll
        for (int j = 0; j < 3; ++j) wq[j] = *(const unsigned*)(QA + (size_t)tok * 384 + 2 * lane + 128 * j);
#pragma unroll
        for (int j = 0; j < 2; ++j) wk[j] = *(const unsigned*)(KVA + (size_t)tok * 256 + 2 * lane + 128 * j);
        const float kpe = bf2f(KPE[(size_t)tok * 64 + lane]);
        float y[6][3], kv[6][4];
#pragma unroll
        for (int h = 0; h < 6; ++h) { y[h][0] = bf2f(qp[h * 192 + lane]); y[h][1] = bf2f(qp[h * 192 + 64 + lane]); y[h][2] = bf2f(qp[h * 192 + 128 + lane]);
            kv[h][0] = bf2f(kvp[h * 256 + lane]); kv[h][1] = bf2f(kvp[h * 256 + 64 + lane]); kv[h][2] = bf2f(kvp[h * 256 + 128 + lane]); kv[h][3] = bf2f(kvp[h * 256 + 192 + lane]); }
        float sq = 0.f, sk = 0.f;
#pragma unroll
        for (int j = 0; j < 3; ++j) { const float a = bflo(wq[j]), b = bfhi(wq[j]); sq += a * a + b * b; }
#pragma unroll
        for (int j = 0; j < 2; ++j) { const float a = bflo(wk[j]), b = bfhi(wk[j]); sk += a * a + b * b; }
        const float rq = rsqrtf(wave_sum(sq) * (1.f / 384.f) + EPS), rk = rsqrtf(wave_sum(sk) * (1.f / 256.f) + EPS);
        float cs = 1.f, sn = 0.f;
        if (tok < NTX) { const int t = tok & 2047; const float pos = (float)((lane >> 5) ? (t & 63) : (t >> 6)); sincosf(pos * invf, &sn, &cs); }
        float sqh[6], skh[6];
#pragma unroll
        for (int h = 0; h < 6; ++h) { y[h][0] *= rq; y[h][1] *= rq; y[h][2] *= rq; kv[h][0] *= rk; kv[h][1] *= rk; kv[h][2] *= rk; kv[h][3] *= rk;
            sqh[h] = y[h][0] * y[h][0] + y[h][1] * y[h][1] + y[h][2] * y[h][2]; skh[h] = kv[h][0] * kv[h][0] + kv[h][1] * kv[h][1] + kpe * kpe; }
#pragma unroll
        for (int o = 1; o < 64; o <<= 1)
#pragma unroll
            for (int h = 0; h < 6; ++h) { sqh[h] += __shfl_xor(sqh[h], o); skh[h] += __shfl_xor(skh[h], o); }
#pragma unroll
        for (int h = 0; h < 6; ++h) {
            float r = rsqrtf(sqh[h] * (1.f / 192.f) + EPS);
            r *= 0.07216878364870322f * 1.4426950408889634f;
            float y0 = y[h][0] * r * qg0, y1 = y[h][1] * r * qg1, y2 = y[h][2] * r * qg2;
            { const float pr = __shfl_xor(y2, 16); const float rot = half ? pr : -pr; y2 = y2 * cs + rot * sn; }
            qp[h * 192 + lane] = (bf16)f2bf(y0); qp[h * 192 + 64 + lane] = (bf16)f2bf(y1); qp[h * 192 + 128 + lane] = (bf16)f2bf(y2);
            r = rsqrtf(skh[h] * (1.f / 192.f) + EPS);
            float k0 = kv[h][0] * r * kg0, k1 = kv[h][1] * r * kg1, k2 = kpe * r * kg2;
            { const float pr = __shfl_xor(k2, 16); const float rot = half ? pr : -pr; k2 = k2 * cs + rot * sn; }
            kp[h * 192 + lane] = (bf16)f2bf(k0); kp[h * 192 + 64 + lane] = (bf16)f2bf(k1); kp[h * 192 + 128 + lane] = (bf16)f2bf(k2);
            kvp[h * 256 + 128 + lane] = (bf16)f2bf(kv[h][2]); kvp[h * 256 + 192 + lane] = (bf16)f2bf(kv[h][3]);
        }
    }
}

__device__ __forceinline__ unsigned cvtpk(float lo, float hi) { unsigned r; asm("v_cvt_pk_bf16_f32 %0, %1, %2" : "=v"(r) : "v"(lo), "v"(hi)); return r; }
__device__ __forceinline__ void attn_unit(int unit, const bf16* Q, const bf16* KK, const bf16* YKV, bf16* MX, LAS unsigned char* L, int tid, int wave, int lane) {
    int b, h, qtok0, ntiles;
    if (unit < 384) { b = unit / 48; h = (unit >> 3) % 6; qtok0 = b * 2048 + (unit & 7) * 256; ntiles = 36; }
    else { const int u2 = unit - 384; b = u2 / 6; h = u2 % 6; qtok0 = NTX + b * 256; ntiles = 4; }
    const int g = lane >> 4, i15 = lane & 15, q4 = i15 >> 2, pp = i15 & 3;
    bf16x8 qf[2][6];
#pragma unroll
    for (int r = 0; r < 2; ++r) { const bf16* qp = Q + (size_t)(qtok0 + 32 * wave + 16 * r + i15) * 1152 + h * 192 + 8 * g;
#pragma unroll
      for (int ks = 0; ks < 6; ++ks) qf[r][ks] = *(const bf16x8*)(qp + 32 * ks); }
    int koff, voff;
    { const int r = 8 * wave + (lane >> 3), c = (lane & 7) ^ ((r >> 1) & 7); koff = r * 1152 + h * 192 + c * 8; }
    { const int r = 4 * wave + (lane >> 4), sl = lane & 15, dt = (sl >> 1) ^ (r & 7), c = 2 * dt + (sl & 1); voff = r * 1536 + h * 256 + 128 + c * 8; }
#define ATT_ISSUE(j, slot) do { const int kt0_ = (j) < 4 ? NTX + b * 256 + 64 * (j) : b * 2048 + 64 * ((j) - 4); \
        const bf16* kg_ = KK + (size_t)kt0_ * 1152 + koff; const bf16* vg_ = YKV + (size_t)kt0_ * 1536 + voff; LAS unsigned char* lb_ = L + (slot) * 40960 + wave * 1024; \
        __builtin_amdgcn_global_load_lds((const unsigned*)kg_, (LAS unsigned*)lb_, 16, 0, 0); \
        __builtin_amdgcn_global_load_lds((const unsigned*)(kg_ + 64), (LAS unsigned*)(lb_ + 8192), 16, 0, 0); \
        __builtin_amdgcn_global_load_lds((const unsigned*)(kg_ + 128), (LAS unsigned*)(lb_ + 16384), 16, 0, 0); \
        __builtin_amdgcn_global_load_lds((const unsigned*)vg_, (LAS unsigned*)(lb_ + 24576), 16, 0, 0); \
        __builtin_amdgcn_global_load_lds((const unsigned*)(vg_ + 32 * 1536), (LAS unsigned*)(lb_ + 24576 + 8192), 16, 0, 0); } while (0)
    const int kx = i15 >> 1, ka0 = i15 * 128 + ((g ^ kx) * 16), ka1 = i15 * 128 + (((4 + g) ^ kx) * 16);
    const int vbase = (4 * g + q4) * 256 + 8 * pp + ((4 * (g & 1) + q4) * 32);
    ATT_ISSUE(0, 0);
    f32x4 oacc[2][8];
#pragma unroll
    for (int r = 0; r < 2; ++r)
#pragma unroll
        for (int dt = 0; dt < 8; ++dt) oacc[r][dt] = (f32x4){0.f, 0.f, 0.f, 0.f};
    float mrun[2] = {0.f, 0.f}; f32x4 lacc[2] = {(f32x4){0.f, 0.f, 0.f, 0.f}, (f32x4){0.f, 0.f, 0.f, 0.f}};
    const bf16x8 ones = {16256, 16256, 16256, 16256, 16256, 16256, 16256, 16256};
    for (int j = 0; j < ntiles; ++j) {
        asm volatile("s_waitcnt vmcnt(0)" ::: "memory");
        __syncthreads();
        if (j + 1 < ntiles) ATT_ISSUE(j + 1, (j + 1) & 1);
        const LAS unsigned char* Kb = L + (j & 1) * 40960; const LAS unsigned char* Vb = Kb + 24576;
        f32x4 s[2][4];
#pragma unroll
        for (int T = 0; T < 4; ++T) { s[0][T] = (f32x4){-mrun[0], -mrun[0], -mrun[0], -mrun[0]}; s[1][T] = (f32x4){-mrun[1], -mrun[1], -mrun[1], -mrun[1]}; }
#define KFRAG(T_, ks_) (*(const LAS bf16x8*)(Kb + ((ks_) >> 1) * 8192 + (T_) * 2048 + (((ks_) & 1) ? ka1 : ka0)))
        bf16x8 kc[3], kn[3];
        kc[0] = KFRAG(0, 0); kc[1] = KFRAG(0, 1); kc[2] = KFRAG(0, 2);
#pragma unroll
        for (int hb = 0; hb < 8; ++hb) { const int T = hb >> 1, k0 = (hb & 1) * 3;
            if (hb < 7) { const int T2 = (hb + 1) >> 1, k2 = ((hb + 1) & 1) * 3; kn[0] = KFRAG(T2, k2); kn[1] = KFRAG(T2, k2 + 1); kn[2] = KFRAG(T2, k2 + 2); }
            __builtin_amdgcn_sched_barrier(0);
#pragma unroll
            for (int i = 0; i < 3; ++i) { s[0][T] = MFMA16(kc[i], qf[0][k0 + i], s[0][T]); s[1][T] = MFMA16(kc[i], qf[1][k0 + i], s[1][T]); }
            __builtin_amdgcn_sched_barrier(0);
            kc[0] = kn[0]; kc[1] = kn[1]; kc[2] = kn[2]; }
#undef KFRAG
#define VFRAG(dt_, k2_) tr2(Vb + (k2_) * 8192 + (vbase ^ ((dt_) << 5)), Vb + (k2_) * 8192 + (vbase ^ ((dt_) << 5)) + 4096)
        bf16x8 vc[2], vn[2];
        vc[0] = VFRAG(0, 0); vc[1] = VFRAG(0, 1);
        bf16x8 pf[2][2]; float mxr[2];
#pragma unroll
        for (int r = 0; r < 2; ++r) {
            float mx = s[r][0][0];
#pragma unroll
            for (int T = 0; T < 4; ++T)
#pragma unroll
                for (int e = 0; e < 4; ++e) mx = fmaxf(mx, s[r][T][e]);
            mx = fmaxf(mx, __shfl_xor(mx, 16)); mx = fmaxf(mx, __shfl_xor(mx, 32)); mxr[r] = mx;
        }
        if (__any((mxr[0] > 8.0f) || (mxr[1] > 8.0f))) {
#pragma unroll
            for (int r = 0; r < 2; ++r) { const float d = mxr[r] > 8.0f ? mxr[r] : 0.f, al = __builtin_amdgcn_exp2f(-d); mrun[r] += d;
#pragma unroll
                for (int T = 0; T < 4; ++T) s[r][T] = s[r][T] - d;
#pragma unroll
                for (int dt = 0; dt < 8; ++dt) oacc[r][dt] = oacc[r][dt] * al;
                lacc[r] = lacc[r] * al; }
        }
#pragma unroll
        for (int r = 0; r < 2; ++r) { u32x4 pw[2];
#pragma unroll
            for (int T = 0; T < 4; ++T) { float p[4];
#pragma unroll
                for (int e = 0; e < 4; ++e) p[e] = __builtin_amdgcn_exp2f(s[r][T][e]);
                pw[T >> 1][2 * (T & 1)] = cvtpk(p[0], p[1]); pw[T >> 1][2 * (T & 1) + 1] = cvtpk(p[2], p[3]); }
            pf[r][0] = __builtin_bit_cast(bf16x8, pw[0]); pf[r][1] = __builtin_bit_cast(bf16x8, pw[1]);
            lacc[r] = MFMA16(ones, pf[r][0], lacc[r]); lacc[r] = MFMA16(ones, pf[r][1], lacc[r]);
        }
#pragma unroll
        for (int dt = 0; dt < 8; ++dt) {
            if (dt < 7) { vn[0] = VFRAG(dt + 1, 0); vn[1] = VFRAG(dt + 1, 1); }
            __builtin_amdgcn_sched_barrier(0);
            oacc[0][dt] = MFMA16(vc[0], pf[0][0], oacc[0][dt]); oacc[1][dt] = MFMA16(vc[0], pf[1][0], oacc[1][dt]);
            oacc[0][dt] = MFMA16(vc[1], pf[0][1], oacc[0][dt]); oacc[1][dt] = MFMA16(vc[1], pf[1][1], oacc[1][dt]);
            __builtin_amdgcn_sched_barrier(0);
            vc[0] = vn[0]; vc[1] = vn[1]; }
#undef VFRAG
    }
#undef ATT_ISSUE
#pragma unroll
    for (int r = 0; r < 2; ++r) { const float inv = 1.f / lacc[r][0];
        bf16* op = MX + (size_t)(qtok0 + 32 * wave + 16 * r + i15) * DM + 256 + h * 128 + 4 * g;
#pragma unroll
        for (int dt = 0; dt < 8; ++dt) { u32x2 o; o.x = cvtpk(oacc[r][dt][0] * inv, oacc[r][dt][1] * inv); o.y = cvtpk(oacc[r][dt][2] * inv, oacc[r][dt][3] * inv); *(u32x2*)(op + 16 * dt) = o; } }
    __syncthreads();
}

#ifndef REP_PRO
#define REP_PRO 1
#endif
#ifndef REP_NORM
#define REP_NORM 1
#endif
#ifndef REP_G1
#define REP_G1 1
#endif
#ifndef REP_GLA
#define REP_GLA 1
#endif
#ifndef REP_GLAC
#define REP_GLAC 1
#endif
#ifndef REP_G2
#define REP_G2 1
#endif
#ifndef REP_G3
#define REP_G3 1
#endif
#ifndef REP_FIN
#define REP_FIN 1
#endif
#ifndef REP_FOUR
#define REP_FOUR 1
#endif
#ifndef REP_ATT
#define REP_ATT 1
#endif
#ifndef REP_G4L0
#define REP_G4L0 1
#endif
#ifndef REP_G4
#define REP_G4 1
#endif
#ifndef REP_G5
#define REP_G5 1
#endif
#ifndef REP_G6
#define REP_G6 1
#endif
#ifndef EXTRA_SYNCS
#define EXTRA_SYNCS 0
#endif
#ifndef EN_PRO
#define EN_PRO 1
#endif
#ifndef EN_NORM
#define EN_NORM 1
#endif
#ifndef EN_G1
#define EN_G1 1
#endif
#ifndef EN_GLA
#define EN_GLA 1
#endif
#ifndef EN_GLAC
#define EN_GLAC 1
#endif
#ifndef EN_G2
#define EN_G2 1
#endif
#ifndef EN_G3
#define EN_G3 1
#endif
#ifndef EN_FIN
#define EN_FIN 1
#endif
#ifndef EN_FOUR
#define EN_FOUR 1
#endif
#ifndef EN_ATT
#define EN_ATT 1
#endif
#ifndef EN_G4
#define EN_G4 1
#endif
#ifndef EN_G5
#define EN_G5 1
#endif
#ifndef EN_G6
#define EN_G6 1
#endif

constexpr int N_PHASES = 37;
__device__ __forceinline__ bool in_phase(LAS unsigned char* L, int k) { const LAS unsigned* p = (const LAS unsigned*)(L + 131072) + 58; const int lo = (int)__builtin_amdgcn_readfirstlane(p[0]), hi = (int)__builtin_amdgcn_readfirstlane(p[1]); return lo <= k && k < hi; }
__global__ void __launch_bounds__(512, 2) mk_fwd(Args a) {
    extern __shared__ __attribute__((aligned(16))) unsigned char lds_raw[];
    LAS unsigned char* L = (LAS unsigned char*)lds_raw;
    cg::grid_group grid = cg::this_grid();
    { const int tid = threadIdx.x;
    if (tid < 29) { const unsigned long long v = tid < 27 ? (unsigned long long)a.in[tid] : (tid == 27 ? (unsigned long long)a.out : (unsigned long long)a.ws);
        ((LAS unsigned*)(L + 131072))[2 * tid] = (unsigned)v; ((LAS unsigned*)(L + 131072))[2 * tid + 1] = (unsigned)(v >> 32); } }
    if (threadIdx.x == 0) { ((LAS unsigned*)(L + 131072))[58] = (unsigned)a.ph_lo; ((LAS unsigned*)(L + 131072))[59] = (unsigned)a.ph_hi; }
    if (threadIdx.x < 2) ((LAS unsigned*)(L + 131072 + 512))[threadIdx.x] = 0u;
    __syncthreads();
    (void)xcd_barrier_post((unsigned*)a.ws, (volatile LAS unsigned*)(L + 131072 + 512));
    const bool lo_dead = a.ph_lo < 0;
#define IN(k) in_phase(L, (k))
#define SEAM(k) do { if (IN(k) && IN((k) + 1)) { if (lo_dead) grid.sync(); else { XcdBarrier xb_; xb_.bar = (unsigned*)WSP; xb_.x = xb_xcc_id(); xb_.st = (volatile LAS unsigned*)(L + 131072 + 512); xcd_barrier(xb_); for (int xs_ = 0; xs_ < EXTRA_SYNCS; ++xs_) xcd_barrier(xb_); } } } while (0)
#define TID_VARS int tid = threadIdx.x; asm volatile("" : "+v"(tid)); const int lane = tid & 63, wave = __builtin_amdgcn_readfirstlane(tid >> 6); (void)lane; (void)wave;
#define LAYER_VARS TID_VARS int l = lc; asm volatile("" : "+s"(l)); const int i2 = l >> 1; const bool need_ctx = l < 3; const int mtok = need_ctx ? NTOK : NTX; unsigned char* ws = WSP; const int G = gridDim.x, bid = blockIdx.x; \
        float* MOD = (float*)(ws + WS_MOD); const float* mod = MOD + (size_t)l * 9 * 6144; bf16* ZX = (bf16*)(ws + WS_ZX); float* HB = (float*)(ws + WS_H); (void)i2; (void)need_ctx; (void)mtok; (void)G; (void)bid; (void)mod; (void)ZX; (void)HB;
    for (int rep_ = 0; rep_ < REP_PRO; ++rep_) if (EN_PRO && IN(0)) { TID_VARS prologue(L, tid, wave, lane); }
    SEAM(0);
#pragma nounroll
    for (int lc = 0; lc < 4; ++lc) {
        const int p0 = 1 + 9 * lc; const bool odd = lc & 1;
        for (int rep_ = 0; rep_ < REP_NORM; ++rep_) if (EN_NORM && IN(p0)) { LAYER_VARS const float* xin = l == 0 ? INP(0) : OUTP; const float* hin = l == 0 ? INP(2) : HB; norm_phase(xin, hin, INP(6) + l * DM, mod, 0, 1, ZX, NTOK, wave, lane, l > 0 ? (const bf16*)(ws + WS_R2) : nullptr, HB); }
        SEAM(p0);
        if (!odd) {
            for (int rep_ = 0; rep_ < REP_G1; ++rep_) if (EN_G1 && IN(p0 + 1)) { LAYER_VARS bf16* P = (bf16*)(ws + WS_R1);
                pg8::Gemm g{ZX, (const bf16*)(ws + WS_WEV) + (size_t)i2 * EVP * 1024, NTOK, EVP, 1024}; pg8::StaticOrder S; S.init(NTOK, EVP, G, bid);
                EpiStore E{P, EVW, EVW}; pg8::gemm_phase<EpiStore, pg8::StaticOrder, true, true>(L, g, S, E); }
            SEAM(p0 + 1);
            for (int rep_ = 0; rep_ < REP_GLA; ++rep_) if (EN_GLA && IN(p0 + 2)) { LAYER_VARS bf16* P = (bf16*)(ws + WS_R1); bf16* U = (bf16*)(ws + WS_R2 + R2_U); float* DD = (float*)(ws + WS_R2 + R2_DD);
                const float *waf = INP(12) + i2 * 4096, *baf = INP(13) + i2 * 256, *wab = INP(14) + i2 * 4096, *bab = INP(15) + i2 * 256;
                for (int u = bid; u < 1152 + 576; u += G) {
                    if (u < 1152) gla_passA(u, P, waf, baf, wab, bab, U, DD, L, tid, wave, lane);
                    else sg_unit(u - 1152, P, INP(17) + i2 * 512, (const bf16*)(ws + WS_SGW) + (size_t)i2 * 65536, INP(19) + i2 * 512, ZX, L, tid, wave, lane);
                } }
            SEAM(p0 + 2);
            for (int rep_ = 0; rep_ < REP_GLA; ++rep_) if (EN_GLA && IN(p0 + 3)) { LAYER_VARS gla_passB((const bf16*)(ws + WS_R2 + R2_U), (const float*)(ws + WS_R2 + R2_DD), (bf16*)(ws + WS_R2 + R2_SB), tid); }
            SEAM(p0 + 3);
            for (int rep_ = 0; rep_ < REP_GLAC; ++rep_) if (EN_GLAC && IN(p0 + 4)) { LAYER_VARS bf16* P = (bf16*)(ws + WS_R1); const bf16* SB = (const bf16*)(ws + WS_R2 + R2_SB);
                const float *waf = INP(12) + i2 * 4096, *baf = INP(13) + i2 * 256, *wab = INP(14) + i2 * 4096, *bab = INP(15) + i2 * 256;
                for (int u = bid; u < 1152; u += G) gla_passC(u, P, waf, baf, wab, bab, SB, INP(16) + i2 * 128, ZX, L, tid, wave, lane); }
            SEAM(p0 + 4);
        } else {
            for (int rep_ = 0; rep_ < REP_G2; ++rep_) if (EN_G2 && IN(p0 + 1)) { LAYER_VARS
                pg8::Gemm g{ZX, (const bf16*)(ws + WS_WOD) + (size_t)i2 * ODP * 1024, NTOK, ODP, 1024}; pg8::StaticOrder S; S.init(NTOK, ODP, G, bid);
                EpiOddIn E{(bf16*)(ws + WS_R1 + R1_QA), (bf16*)(ws + WS_R1 + R1_KVA), (bf16*)(ws + WS_R1 + R1_KPE), (bf16*)(ws + WS_R1 + R1_FBX), (bf16*)(ws + WS_R1 + R1_FBC)};
                pg8::gemm_phase<EpiOddIn, pg8::StaticOrder, true, true>(L, g, S, E); }
            SEAM(p0 + 1);
            for (int rep_ = 0; rep_ < REP_G3; ++rep_) if (EN_G3 && IN(p0 + 2)) {
#pragma nounroll
                for (int wq = 0; wq < 2; ++wq) { LAYER_VARS int w = wq; asm volatile("" : "+s"(w));
                    const bf16* A = (const bf16*)(ws + WS_R1 + (w ? R1_KVA : R1_QA)); const bf16* Bt = w ? (const bf16*)(ws + WS_WUKV) + (size_t)i2 * 1536 * 256 : (const bf16*)(ws + WS_WUQ) + (size_t)i2 * 1280 * 384;
                    const int Kk = w ? 256 : 384, Np = w ? 1536 : 1280, Nv = w ? 1536 : 1152; bf16* O = w ? (bf16*)(ws + WS_R2 + R2_YKV) : (bf16*)(ws + WS_R1 + R1_YQ);
                    pg8::Gemm g{A, Bt, NTOK, Np, Kk}; pg8::StaticOrder S; S.init(NTOK, Np, G, bid);
                    EpiStore E{O, Nv, Nv}; pg8::gemm_phase<EpiStore, pg8::StaticOrder, true, true>(L, g, S, E); } }
            SEAM(p0 + 2);
            for (int rep_ = 0; rep_ < REP_FIN; ++rep_) if (EN_FIN && IN(p0 + 3)) { LAYER_VARS mla_finalize((bf16*)(ws + WS_R1 + R1_QA), (bf16*)(ws + WS_R1 + R1_KVA), (bf16*)(ws + WS_R1 + R1_KPE), (bf16*)(ws + WS_R1 + R1_YQ), (bf16*)(ws + WS_R2 + R2_YKV), (bf16*)(ws + WS_R2 + R2_KK), INP(25) + i2 * 192, INP(26) + i2 * 192, wave, lane); }
            SEAM(p0 + 3);
            for (int rep_ = 0; rep_ < REP_FOUR; ++rep_) if (EN_FOUR && IN(p0 + 4)) {
#pragma nounroll
                for (int wq = 0; wq < 2; ++wq) { LAYER_VARS int w = wq; asm volatile("" : "+s"(w)); const int NF = G >= 128 ? 64 : G;
                    if (bid < NF && (w == 0 || need_ctx)) {
                        const bf16* A = (const bf16*)(ws + (w ? WS_DFTC : WS_DFTX)); const bf16* Bt = (const bf16*)(ws + WS_R1 + (w ? R1_FBC : R1_FBX));
                        const int Mm = w ? 256 : 2048, Kk = w ? 512 : 4096;
                        pg8::Gemm g{A, Bt, Mm, 2048, Kk}; pg8::StaticOrder S; S.init(Mm, 2048, NF, bid);
                        EpiFourier E{ZX, w ? NTX : 0, Mm, w ? 0.0078125f : 0.00276213586400995f}; pg8::gemm_phase<EpiFourier, pg8::StaticOrder, true, true>(L, g, S, E); } } }
            for (int rep_ = 0; rep_ < REP_ATT; ++rep_) if (EN_ATT && IN(p0 + 4)) { LAYER_VARS const int NF = G >= 128 ? 64 : 0, GA = G - NF, ba = bid - NF;
                const int nun = need_ctx ? 432 : 384;
                if (ba >= 0) for (int v = ba; v < nun; v += GA) { int u = v;
                    if (G == 256) { const int x = v & 7, li = (v % 192) >> 3, i = v / 192; if (i < 2) { const int lu = li + 24 * i; u = (x + 8 * (lu >> 3)) * 8 + (lu & 7); } else u = 384 + x + 8 * li; }
                    attn_unit(u, (bf16*)(ws + WS_R1 + R1_YQ), (bf16*)(ws + WS_R2 + R2_KK), (bf16*)(ws + WS_R2 + R2_YKV), ZX, L, tid, wave, lane); } }
            SEAM(p0 + 4);
        }
        for (int rep_ = 0; rep_ < (lc == 0 ? REP_G4L0 : REP_G4); ++rep_) if (EN_G4 && IN(p0 + 5)) { LAYER_VARS const float* xin = l == 0 ? INP(0) : OUTP; const float* hin = l == 0 ? INP(2) : HB;
            pg8::Gemm g{ZX, (const bf16*)(ws + WS_WMIX) + (size_t)l * DM * DM, mtok, DM, DM};
            pg8::TailOrder S; S.init(DM, G, bid, need_ctx ? 256 : 0); EpiResid E{xin, hin, OUTP, HB, mod + 2 * 1024, (bf16*)(ws + WS_R2)}; pg8::gemm_phase<EpiResid, pg8::TailOrder, true, true>(L, g, S, E); }
        SEAM(p0 + 5);
        for (int rep_ = 0; rep_ < REP_NORM; ++rep_) if (EN_NORM && IN(p0 + 6)) { LAYER_VARS { const float* hin = l == 0 ? INP(2) : HB; norm_phase(OUTP, hin, INP(7) + l * DM, mod, 3, 4, ZX, mtok, wave, lane, need_ctx ? (const bf16*)(ws + WS_R2) : nullptr, HB); } }
        SEAM(p0 + 6);
        for (int rep_ = 0; rep_ < REP_G5; ++rep_) if (EN_G5 && IN(p0 + 7)) { LAYER_VARS
            pg8::Gemm g{ZX, (const bf16*)(ws + WS_WFI) + (size_t)l * 5632 * 1024, mtok, 5632, 1024}; pg8::StaticOrder S; S.init(mtok, 5632, G, bid);
            EpiSwiglu E{(bf16*)(ws + WS_R1)}; pg8::gemm_phase<EpiSwiglu, pg8::StaticOrder, true, true>(L, g, S, E); }
        SEAM(p0 + 7);
        for (int rep_ = 0; rep_ < REP_G6; ++rep_) if (EN_G6 && IN(p0 + 8)) { LAYER_VARS float* outp = OUTP;
            pg8::Gemm g{(bf16*)(ws + WS_R1), (const bf16*)(ws + WS_WFO) + (size_t)l * DM * FF, mtok, DM, FF};
            pg8::TailOrder S; S.init(FF, G, bid, need_ctx ? 256 : 0); EpiResid E{outp, HB, outp, HB, mod + 5 * 1024, (bf16*)(ws + WS_R2)}; pg8::gemm_phase<EpiResid, pg8::TailOrder, true, true>(L, g, S, E); }
        SEAM(p0 + 8);
    }
#undef IN
#undef SEAM
}

#ifndef MK_PER_PHASE
#define MK_PER_PHASE 0
#endif
extern "C" void kernel_launch(void* const* d_in, const int* in_sizes, int n_in, void* d_out, int out_size, void* d_ws, size_t ws_size, hipStream_t stream) {
    static int grid = 0;
    if (grid == 0) {
        if (n_in != 27 || ws_size < WS_END) { fprintf(stderr, "kernel_launch: need 27 inputs and >= %zu bytes of workspace (got %d, %zu)\n", (size_t)WS_END, n_in, ws_size); grid = -1; return; }
        int dev = 0, cus = 0, per_cu = 0;
        hipGetDevice(&dev); hipDeviceGetAttribute(&cus, hipDeviceAttributeMultiprocessorCount, dev);
        if (hipFuncSetAttribute((const void*)mk_fwd, hipFuncAttributeMaxDynamicSharedMemorySize, LDS_BYTES) != hipSuccess) { fprintf(stderr, "kernel_launch: hipFuncSetAttribute failed\n"); grid = -1; return; }
        if (hipOccupancyMaxActiveBlocksPerMultiprocessor(&per_cu, (const void*)mk_fwd, 512, LDS_BYTES) != hipSuccess || per_cu < 1) { fprintf(stderr, "kernel_launch: occupancy query says %d\n", per_cu); per_cu = 1; }
        (void)hipGetLastError();
        grid = cus * 1;
    }
    if (grid < 0) return;
    if (hipMemsetAsync(d_ws, 0, 16384, stream) != hipSuccess) { fprintf(stderr, "kernel_launch: memset of the barrier words failed\n"); return; }
    Args a{};
    for (int i = 0; i < 27; ++i) a.in[i] = (const float*)d_in[i];
    a.out = (float*)d_out; a.ws = (unsigned char*)d_ws;
#if MK_PER_PHASE
    for (int p = 0; p < N_PHASES; ++p) { a.ph_lo = p; a.ph_hi = p + 1; hipLaunchKernelGGL(mk_fwd, dim3(grid), dim3(512), LDS_BYTES, stream, a); }
#else
    a.ph_lo = 0; a.ph_hi = N_PHASES;
    void* args[] = {&a};
    hipError_t e = hipLaunchCooperativeKernel((const void*)mk_fwd, dim3(grid), dim3(512), args, LDS_BYTES, stream);
    if (e != hipSuccess) fprintf(stderr, "kernel_launch: cooperative launch failed: %s (grid %d)\n", hipGetErrorString(e), grid);
#endif
}
```

```cpp
#include <hip/hip_runtime.h>
#include <hip/hip_cooperative_groups.h>
#include <cstdio>
#include <cstdint>
#include <cmath>
namespace cg = cooperative_groups;
namespace pg8 {
#define PG8_LAS __attribute__((address_space(3)))
typedef unsigned short bf16_t;
typedef short bf16x8 __attribute__((ext_vector_type(8)));
typedef float f32x4 __attribute__((ext_vector_type(4)));
typedef unsigned u32x4 __attribute__((ext_vector_type(4)));
constexpr int BM = 256, BK = 64, HALF = 128, HTB = HALF * BK * 2  , STAGE_BYTES = 8 * HTB, NXCD = 8, WGM = 8;

__host__ __device__ __forceinline__ int lds_byte(int r, int c) { const int st = (r >> 4) * 2 + (c >> 5), rr = r & 15, cc = c & 31, ob = rr * 64 + cc * 2; return st * 1024 + (ob ^ (((ob >> 9) & 1) << 5)); }
__host__ __device__ __forceinline__ void stage_rc(int b, int& R, int& C) { const int st = b / 1024, sb = b % 1024, swz = sb ^ (((sb >> 9) & 1) << 5); R = (st >> 1) * 16 + swz / 64; C = (st & 1) * 32 + (swz % 64) / 2; }
__host__ __device__ __forceinline__ int perm32(int rho) { const int n = rho >> 4, i = rho & 15; return 8 * (i >> 2) + 4 * n + (i & 3); }

struct Unit { int pm, pn, kb, nt, ks; };
struct Gemm { const bf16_t* A; const bf16_t* Bt; int M, N, K; };

struct StaticOrder {
    int nM, nN, nwg, G, c;
    __host__ __device__ __forceinline__ void init(int M, int N, int G_, int c_) { nM = M / BM; nN = N / BM; nwg = nM * nN; G = G_; c = c_; }
    __host__ __device__ __forceinline__ bool next(int i, Unit& u) const {
        const long L = (long)i * G + c; if (L >= nwg) return false;
        int wgid = (int)L; { const int q = nwg / NXCD, r = nwg % NXCD, xcd = wgid % NXCD, off = wgid / NXCD; wgid = (xcd < r ? xcd * (q + 1) : r * (q + 1) + (xcd - r) * q) + off; }
        const int nig = WGM * nN, gid = wgid / nig, fm = gid * WGM, gsz = (nM - fm) < WGM ? (nM - fm) : WGM;
        u.pm = fm + ((wgid % nig) % gsz); u.pn = (wgid % nig) / gsz; u.kb = 0; u.nt = 0; u.ks = 0; return true;
    }
    __device__ __forceinline__ void a_ready(const Unit&) const {}
    __device__ __forceinline__ void done(const Unit&) const {}
};

__device__ __forceinline__ unsigned cvt_pk_bf16(float lo, float hi) { unsigned r; asm volatile("v_cvt_pk_bf16_f32 %0, %1, %2" : "=v"(r) : "v"(lo), "v"(hi)); return r; }
typedef float f32x2 __attribute__((ext_vector_type(2)));

struct TailOrder {
    StaticOrder so; int G, c, pairs, nw, ntail;
    __host__ __device__ __forceinline__ void init(int K, int G_, int c_, int ntail_) { so.init(16384, 1024, G_, c_); G = G_; c = c_; pairs = K / 128; nw = c_ < 256 ? (256 - c_ + G_ - 1) / G_ : 0; ntail = ntail_; }
    __host__ __device__ __forceinline__ bool next(int i, Unit& u) const {
        int pm = 0, pn = 0, kb = 0, nt = 0, ks = 0; bool ok;
        if (i < nw) {
            const int L0 = i * G + c; ok = L0 < 256; int wgid = L0 & 255; { const int xcd = wgid % NXCD, off = wgid / NXCD; wgid = xcd * 32 + off; }
            const int nig = WGM * 4, gid = wgid / nig, fm = gid * WGM; pm = fm + ((wgid % nig) % WGM); pn = (wgid % nig) / WGM;
        } else {
            const int j = (i - nw) * G + c; ok = j < ntail; const int tu = (j & 255) >> 3, s = j & 7, base = pairs >> 3, rem = pairs & 7;
            pm = 64 + (tu >> 2); pn = tu & 3; ks = s; nt = 2 * (base + (s < rem ? 1 : 0)); kb = 128 * (s * base + (s < rem ? s : rem));
        }
        u.pm = pm; u.pn = pn; u.kb = kb; u.nt = nt; u.ks = ks; return ok;
    }
    __device__ __forceinline__ void a_ready(const Unit&) const {}
    __device__ __forceinline__ void done(const Unit&) const {}
};

struct LdsOrder {
    __attribute__((address_space(3))) int* p;
    template <class S> __device__ __forceinline__ void fill(const S& s, int tid) {
        if (tid == 0) { for (int i = 0; i < 9; ++i) { Unit u; u.pm = 0; u.pn = 0; u.kb = 0; u.nt = 0; u.ks = 0; const bool ok = s.next(i, u); p[i * 8 + 0] = ok ? u.pm : -1; p[i * 8 + 1] = u.pn; p[i * 8 + 2] = u.kb; p[i * 8 + 3] = u.nt; p[i * 8 + 4] = u.ks; if (!ok) break; } }
        __syncthreads();
    }
    __device__ __forceinline__ bool next(int i, Unit& u) const {
        const int pm = __builtin_amdgcn_readfirstlane(p[i * 8 + 0]); if (pm < 0) return false;
        u.pm = pm; u.pn = __builtin_amdgcn_readfirstlane(p[i * 8 + 1]); u.kb = __builtin_amdgcn_readfirstlane(p[i * 8 + 2]); u.nt = __builtin_amdgcn_readfirstlane(p[i * 8 + 3]); u.ks = __builtin_amdgcn_readfirstlane(p[i * 8 + 4]); return true;
    }
    __device__ __forceinline__ void a_ready(const Unit&) const {}
    __device__ __forceinline__ void done(const Unit&) const {}
};
template <class Epi, class Sched, bool ALIGN_EPI = false, bool SP2 = false>
__device__ __forceinline__ void gemm_phase(PG8_LAS unsigned char* lds, const Gemm g, const Sched& S, const Epi& E) {
    int tid = threadIdx.x; asm volatile("" : "+v"(tid));
    const int wid = __builtin_amdgcn_readfirstlane(tid >> 6), lane = tid & 63, wr = wid >> 2, wc = wid & 3, fr = lane & 15, fq = lane >> 4;
    const int K = g.K, nt = K / BK;
    unsigned voffA[2], voffB[2];
#pragma unroll
    for (int i = 0; i < 2; ++i) { int R, C; stage_rc(tid * 16 + i * 8192, R, C); const int Rb = Epi::PERM ? ((R & ~31) + perm32(R & 31)) : R;
        voffA[i] = (unsigned)(R * K + C) * 2u; voffB[i] = (unsigned)(Rb * K + C) * 2u; }
    const size_t kstep = (size_t)(BK * 2);
    const size_t hstep = (size_t)HALF * K * 2;
    const size_t tstep = 2 * hstep;
    const unsigned ldsw = (unsigned)wid * 1024u;
    const int aoff = lds_byte(wr * 64 + fr, fq * 8), boff = lds_byte(wc * 32 + fr, fq * 8);
#define PG8_SA(b, h) (((b) * 2 + (h)) * HTB)
#define PG8_SB(b, h) ((4 + (b) * 2 + (h)) * HTB)
#define PG8_STAGE(bufoff, gbase, voff) do { _Pragma("unroll") for (int _i = 0; _i < 2; ++_i) \
        __builtin_amdgcn_global_load_lds((const unsigned*)((const char*)(gbase) + (voff)[_i]), (PG8_LAS unsigned*)(lds + (bufoff) + ldsw + _i * 8192), 16, 0, 0); } while (0)
#define PG8_LDA(dst, b, h) do { _Pragma("unroll") for (int m = 0; m < 4; ++m) _Pragma("unroll") for (int k = 0; k < 2; ++k) dst[m][k] = *(const PG8_LAS bf16x8*)(lds + PG8_SA(b, h) + aoff + m * 2048 + k * 1024); } while (0)
#define PG8_LDB(dst, b, h) do { _Pragma("unroll") for (int n = 0; n < 2; ++n) _Pragma("unroll") for (int k = 0; k < 2; ++k) dst[n][k] = *(const PG8_LAS bf16x8*)(lds + PG8_SB(b, h) + boff + n * 2048 + k * 1024); } while (0)
#define PG8_MMA(ai, bj, At, Bt) do { __builtin_amdgcn_s_setprio(1); _Pragma("unroll") for (int m = 0; m < 4; ++m) _Pragma("unroll") for (int n = 0; n < 2; ++n) _Pragma("unroll") for (int k = 0; k < 2; ++k) \
        acc[ai][bj][m][n] = __builtin_amdgcn_mfma_f32_16x16x32_bf16(Bt[n][k], At[m][k], acc[ai][bj][m][n], 0, 0, 0); __builtin_amdgcn_s_setprio(0); } while (0)
#define PG8_WAIT_V(n) asm volatile("s_waitcnt vmcnt(" #n ")" ::: "memory")
#define PG8_WAIT_L(n) asm volatile("s_waitcnt lgkmcnt(" #n ")" ::: "memory")
#define PG8_BAR __builtin_amdgcn_s_barrier()
#define PG8_SCHED __builtin_amdgcn_sched_barrier(0)
    Unit cur, nxt; int ui = 0;
    if (!S.next(0, cur)) return;
    f32x4 acc[2][2][4][2];
#pragma unroll
    for (int a = 0; a < 2; ++a)
#pragma unroll
        for (int b = 0; b < 2; ++b)
#pragma unroll
            for (int m = 0; m < 4; ++m)
#pragma unroll
                for (int n = 0; n < 2; ++n) acc[a][b][m][n] = (f32x4){0.f, 0.f, 0.f, 0.f};
    bf16x8 At[4][2], B0[2][2], B1[2][2];
    const char* cA = (const char*)g.A + (size_t)cur.pm * tstep + (size_t)cur.kb * 2; const char* cB = (const char*)g.Bt + (size_t)cur.pn * tstep + (size_t)cur.kb * 2;
    S.a_ready(cur);
    if constexpr (SP2) {
        PG8_STAGE(PG8_SB(0, 0), cB, voffB); PG8_STAGE(PG8_SB(0, 1), cB + hstep, voffB); PG8_STAGE(PG8_SA(0, 0), cA, voffA); PG8_STAGE(PG8_SA(0, 1), cA + hstep, voffA);
        if (wr == 1) PG8_BAR;
        PG8_WAIT_V(2); PG8_BAR;
        PG8_STAGE(PG8_SB(1, 0), cB + kstep, voffB); PG8_STAGE(PG8_SA(1, 0), cA + kstep, voffA); PG8_STAGE(PG8_SB(1, 1), cB + hstep + kstep, voffB);
        PG8_WAIT_V(6); PG8_BAR;
    } else {
        PG8_STAGE(PG8_SB(0, 0), cB, voffB); PG8_STAGE(PG8_SA(0, 0), cA, voffA); PG8_STAGE(PG8_SB(0, 1), cB + hstep, voffB); PG8_STAGE(PG8_SA(0, 1), cA + hstep, voffA);
        if (wr == 1) PG8_BAR;
        PG8_WAIT_V(4); PG8_BAR;
        PG8_STAGE(PG8_SB(1, 0), cB + kstep, voffB); PG8_STAGE(PG8_SA(1, 0), cA + kstep, voffA); PG8_STAGE(PG8_SB(1, 1), cB + hstep + kstep, voffB);
        PG8_WAIT_V(6); PG8_BAR;
    }
    for (;;) {
        const bool has_next = S.next(ui + 1, nxt);
        const char* nA = has_next ? (const char*)g.A + (size_t)nxt.pm * tstep + (size_t)nxt.kb * 2 : cA; const char* nB = has_next ? (const char*)g.Bt + (size_t)nxt.pn * tstep + (size_t)nxt.kb * 2 : cB;
        const int unt = cur.nt ? cur.nt : nt;
        for (int t = 0; t < unt; t += 2) {
            const bool last = (t == unt - 2);
            const char* a1 = cA + (size_t)(t + 1) * kstep;
            const char* a2 = last ? nA : cA + (size_t)(t + 2) * kstep; const char* b2 = last ? nB : cB + (size_t)(t + 2) * kstep;
            const char* a3 = a2 + kstep; const char* b3 = b2 + kstep;
            if (last && has_next) S.a_ready(nxt);
            if constexpr (SP2) {
            PG8_LDB(B0, 0, 0); PG8_LDB(B1, 0, 1); PG8_SCHED; PG8_LDA(At, 0, 0); PG8_STAGE(PG8_SA(1, 1), a1 + hstep, voffA);
            PG8_WAIT_V(8); PG8_WAIT_L(0); PG8_BAR; PG8_MMA(0, 0, At, B0); PG8_MMA(0, 1, At, B1); PG8_BAR; PG8_SCHED;
            PG8_LDA(At, 0, 1); PG8_STAGE(PG8_SB(0, 0), b2, voffB); PG8_STAGE(PG8_SB(0, 1), b2 + hstep, voffB); PG8_STAGE(PG8_SA(0, 0), a2, voffA);
            PG8_WAIT_V(8); PG8_WAIT_L(0); PG8_BAR; PG8_MMA(1, 0, At, B0); PG8_MMA(1, 1, At, B1); PG8_BAR; PG8_SCHED;
            PG8_LDB(B0, 1, 0); PG8_LDB(B1, 1, 1); PG8_SCHED; PG8_LDA(At, 1, 0); PG8_STAGE(PG8_SA(0, 1), a2 + hstep, voffA);
            PG8_WAIT_V(8); PG8_WAIT_L(0); PG8_BAR; PG8_MMA(0, 0, At, B0); PG8_MMA(0, 1, At, B1); PG8_BAR; PG8_SCHED;
            PG8_LDA(At, 1, 1); PG8_STAGE(PG8_SB(1, 0), b3, voffB); PG8_STAGE(PG8_SB(1, 1), b3 + hstep, voffB); PG8_STAGE(PG8_SA(1, 0), a3, voffA);
            PG8_WAIT_V(8); PG8_WAIT_L(0); PG8_BAR; PG8_MMA(1, 0, At, B0); PG8_MMA(1, 1, At, B1); PG8_BAR; PG8_SCHED;
            } else {
            PG8_LDB(B0, 0, 0); PG8_SCHED; PG8_LDA(At, 0, 0); PG8_STAGE(PG8_SA(1, 1), a1 + hstep, voffA);
            PG8_WAIT_L(8); PG8_BAR; PG8_WAIT_L(0); PG8_MMA(0, 0, At, B0); PG8_BAR; PG8_SCHED;
            PG8_LDB(B1, 0, 1); PG8_STAGE(PG8_SB(0, 0), b2, voffB);
            PG8_BAR; PG8_WAIT_L(0); PG8_MMA(0, 1, At, B1); PG8_BAR;
            PG8_LDA(At, 0, 1); PG8_STAGE(PG8_SA(0, 0), a2, voffA);
            PG8_BAR; PG8_WAIT_L(0); PG8_MMA(1, 0, At, B0); PG8_BAR; PG8_SCHED;
            PG8_STAGE(PG8_SB(0, 1), b2 + hstep, voffB);
            PG8_WAIT_V(6); PG8_BAR; PG8_MMA(1, 1, At, B1); PG8_BAR;
            PG8_LDB(B0, 1, 0); PG8_SCHED; PG8_LDA(At, 1, 0); PG8_STAGE(PG8_SA(0, 1), a2 + hstep, voffA);
            PG8_WAIT_L(8); PG8_BAR; PG8_WAIT_L(0); PG8_MMA(0, 0, At, B0); PG8_BAR; PG8_SCHED;
            PG8_LDB(B1, 1, 1); PG8_STAGE(PG8_SB(1, 0), b3, voffB);
            PG8_BAR; PG8_WAIT_L(0); PG8_MMA(0, 1, At, B1); PG8_BAR;
            PG8_LDA(At, 1, 1); PG8_STAGE(PG8_SA(1, 0), a3, voffA);
            PG8_BAR; PG8_WAIT_L(0); PG8_MMA(1, 0, At, B0); PG8_BAR; PG8_SCHED;
            PG8_STAGE(PG8_SB(1, 1), b3 + hstep, voffB);
            PG8_WAIT_V(6); PG8_BAR; PG8_MMA(1, 1, At, B1); PG8_BAR;
            }
        }
        if constexpr (ALIGN_EPI) { if (wr == 0) PG8_BAR; }
        if constexpr (!Epi::AFTER_DRAIN) { E(acc, cur, wr, wc, fr, fq); S.done(cur); }
        if (!has_next) break;
#pragma unroll
        for (int a = 0; a < 2; ++a)
#pragma unroll
            for (int b = 0; b < 2; ++b)
#pragma unroll
                for (int m = 0; m < 4; ++m)
#pragma unroll
                    for (int n = 0; n < 2; ++n) acc[a][b][m][n] = (f32x4){0.f, 0.f, 0.f, 0.f};
        cur = nxt; cA = nA; cB = nB; ++ui;
        if constexpr (ALIGN_EPI) { if (wr == 1) PG8_BAR; }
    }
    PG8_WAIT_V(0);
    if constexpr (!ALIGN_EPI) { if (wr == 0) PG8_BAR; }
    PG8_BAR;
    if constexpr (Epi::AFTER_DRAIN) { E.fused(acc, cur, wr, wc, fr, fq, lds, wid, lane); S.done(cur); }
#undef PG8_SA
#undef PG8_SB
#undef PG8_STAGE
#undef PG8_LDA
#undef PG8_LDB
#undef PG8_MMA
#undef PG8_WAIT_V
#undef PG8_WAIT_L
#undef PG8_BAR
#undef PG8_SCHED
}
}

#define LAS __attribute__((address_space(3)))
typedef unsigned short bf16;
typedef short bf16x8 __attribute__((ext_vector_type(8)));
typedef short v4i16_t __attribute__((ext_vector_type(4)));
typedef float f32x4 __attribute__((ext_vector_type(4)));
typedef float f32x2 __attribute__((ext_vector_type(2)));
typedef unsigned u32x4 __attribute__((ext_vector_type(4)));
typedef unsigned u32x2 __attribute__((ext_vector_type(2)));

constexpr int NTX = 16384, NTC = 2048, NTOK = 18432, DM = 1024, FF = 2816;
constexpr int EVW = 2592, EVP = 2816, ODP = 1280;
constexpr float EPS = 1e-6f;
constexpr size_t MiB = 1u << 20;
constexpr size_t WS_MOD = 1 * MiB, WS_WEV = 2 * MiB, WS_WOD = 13 * MiB, WS_WUQ = 18 * MiB, WS_WUKV = 20 * MiB, WS_WMIX = 22 * MiB,
                 WS_WFI = 30 * MiB, WS_WFO = 74 * MiB, WS_SGW = 96 * MiB, WS_DFTC = 96 * MiB + 512 * 1024, WS_DFTX = 97 * MiB, WS_H = 113 * MiB,
                 WS_ZX = 121 * MiB, WS_R1 = 157 * MiB, WS_R2 = 256 * MiB, WS_END = 366 * MiB;
constexpr size_t R1_QA = 0, R1_KVA = 14 * MiB, R1_KPE = 23 * MiB, R1_FBX = 26 * MiB, R1_FBC = 42 * MiB, R1_YQ = 44 * MiB;
constexpr size_t R2_U = 0, R2_DD = 72 * MiB, R2_SB = 73 * MiB, R2_YKV = 0, R2_KK = 54 * MiB;
constexpr int LDS_BYTES = 131072 + 1024;

struct Args { const float* in[27]; float* out; unsigned char* ws; int ph_lo, ph_hi; };

__device__ __forceinline__ unsigned f2bf(float f) { unsigned u = __float_as_uint(f); return (u + 0x7fffu + ((u >> 16) & 1u)) >> 16; }
__device__ __forceinline__ unsigned pk2(float lo, float hi) { unsigned r; asm("v_cvt_pk_bf16_f32 %0, %1, %2" : "=v"(r) : "v"(lo), "v"(hi)); return r; }
__device__ __forceinline__ float bf2f(bf16 h) { return __uint_as_float((unsigned)h << 16); }
__device__ __forceinline__ float bflo(unsigned w) { return __uint_as_float(w << 16); }
__device__ __forceinline__ float bfhi(unsigned w) { return __uint_as_float(w & 0xffff0000u); }
__device__ __forceinline__ float wave_sum(float v) {
#pragma unroll
    for (int o = 1; o < 64; o <<= 1) v += __shfl_xor(v, o);
    return v;
}
__device__ __forceinline__ float silu_f(float x) { return x * __builtin_amdgcn_rcpf(1.f + __expf(-x)); }
__device__ __forceinline__ float gelu_f(float v) {
    const float t = __builtin_amdgcn_rcpf(fabsf(v) * 0.2316418882f + 1.0f);
    float q = t * 0.5307027145f + (-0.7265760135f); q = q * t + 0.7107068705f; q = q * t + (-0.142248368f); q = q * t + 0.127414796f; q = q * t;
    const float m = v * (q * __builtin_amdgcn_exp2f(v * v * (-0.72134752044f)));
    return v < 0.f ? m : v - m;
}
__device__ __forceinline__ float logsig_f(float y) { return fminf(y, 0.f) - __logf(1.f + __expf(-fabsf(y))); }
#define LDS_WAIT() asm volatile("s_waitcnt lgkmcnt(0)" ::: "memory")
__device__ __forceinline__ bf16x8 tr2(const LAS unsigned char* p1, const LAS unsigned char* p2) {
    v4i16_t lo = __builtin_amdgcn_ds_read_tr16_b64_v4i16((LAS v4i16_t*)p1);
    v4i16_t hi = __builtin_amdgcn_ds_read_tr16_b64_v4i16((LAS v4i16_t*)p2);
    return (bf16x8){lo[0], lo[1], lo[2], lo[3], hi[0], hi[1], hi[2], hi[3]};
}
#define MFMA16(a, b, c) __builtin_amdgcn_mfma_f32_16x16x32_bf16((a), (b), (c), 0, 0, 0)

struct EpiStore {
    static constexpr bool PERM = true, AFTER_DRAIN = false;
    bf16* O; int ldc; int ncols;
    __device__ __forceinline__ void operator()(const pg8::f32x4 (&acc)[2][2][4][2], const pg8::Unit& u, int wr, int wc, int fr, int fq) const {
        const int row0 = u.pm * 256 + wr * 64 + fr, col0 = u.pn * 256 + wc * 32 + 8 * fq;
#pragma unroll
        for (int ai = 0; ai < 2; ++ai)
#pragma unroll
            for (int m = 0; m < 4; ++m) { bf16* rowp = O + (size_t)(row0 + ai * 128 + m * 16) * ldc;
#pragma unroll
                for (int bj = 0; bj < 2; ++bj) { const int col = col0 + bj * 128;
                    if (col < ncols) { const pg8::f32x4 v0 = acc[ai][bj][m][0], v1 = acc[ai][bj][m][1]; u32x4 w; w.x = pk2(v0[0], v0[1]); w.y = pk2(v0[2], v0[3]); w.z = pk2(v1[0], v1[1]); w.w = pk2(v1[2], v1[3]);
                        *(u32x4*)(rowp + col) = w; } } }
    }
};
struct EpiOddIn {
    static constexpr bool PERM = true, AFTER_DRAIN = false;
    bf16 *QA, *KVA, *KPE, *FBX, *FBC;
    __device__ __forceinline__ void operator()(const pg8::f32x4 (&acc)[2][2][4][2], const pg8::Unit& u, int wr, int wc, int fr, int fq) const {
        if (u.pn >= 2) {
            const int row0 = u.pm * 256 + wr * 64 + fr, col0 = (u.pn - 2) * 256 + wc * 32 + 8 * fq;
#pragma unroll
            for (int ai = 0; ai < 2; ++ai)
#pragma unroll
                for (int m = 0; m < 4; ++m) { const size_t row = (size_t)(row0 + ai * 128 + m * 16);
#pragma unroll
                    for (int bj = 0; bj < 2; ++bj) { const int col = col0 + bj * 128;
                        if (col < 704) { const pg8::f32x4 v0 = acc[ai][bj][m][0], v1 = acc[ai][bj][m][1]; u32x4 w; w.x = pk2(v0[0], v0[1]); w.y = pk2(v0[2], v0[3]); w.z = pk2(v1[0], v1[1]); w.w = pk2(v1[2], v1[3]);
                            bf16* dst = col < 384 ? QA + row * 384 + col : (col < 640 ? KVA + row * 256 + (col - 384) : KPE + row * 64 + (col - 640));
                            *(u32x4*)dst = w; } } }
        } else {
            bf16* base; int stride, t0;
            if (u.pm < 64) { base = FBX + (size_t)(u.pm >> 3) * 256 * 4096 + u.pn * 2048; stride = 4096; t0 = (u.pm & 7) * 256; }
            else { base = FBC + (size_t)(u.pm - 64) * 256 * 512 + u.pn * 256; stride = 512; t0 = 0; }
#pragma unroll
            for (int ai = 0; ai < 2; ++ai)
#pragma unroll
                for (int m = 0; m < 4; ++m) { const int t = t0 + ai * 128 + wr * 64 + m * 16 + fr;
#pragma unroll
                    for (int bj = 0; bj < 2; ++bj)
#pragma unroll
                        for (int n = 0; n < 2; ++n)
#pragma unroll
                            for (int e = 0; e < 4; ++e) { const int c = bj * 128 + wc * 32 + 8 * fq + 4 * n + e; base[(size_t)c * stride + t] = (bf16)f2bf(acc[ai][bj][m][n][e]); } }
        }
    }
};
struct EpiResid {
    static constexpr bool PERM = true, AFTER_DRAIN = false;
    const float* xb; const float* hb; float* xo; float* ho; const float* gate; bf16* T;
    __device__ __forceinline__ void operator()(const pg8::f32x4 (&acc)[2][2][4][2], const pg8::Unit& u, int wr, int wc, int fr, int fq) const {
        const bool isx = u.pm < 64; const int mr = isx ? (u.pm >> 3) : 8;
        const int rbase = isx ? u.pm * 256 : (u.pm - 64) * 256;
        const float* gp = gate + (size_t)mr * 6144; const int col0 = u.pn * 256 + wc * 32 + 8 * fq;
        if (!isx) { bf16* tp = T + (size_t)u.ks * 2048 * DM;
#pragma unroll
            for (int bj = 0; bj < 2; ++bj) { const int c = col0 + bj * 128; const pg8::f32x4 g0 = *(const pg8::f32x4*)(gp + c), g1 = *(const pg8::f32x4*)(gp + c + 4);
#pragma unroll
                for (int ai = 0; ai < 2; ++ai)
#pragma unroll
                    for (int m = 0; m < 4; ++m) { const size_t off = (size_t)(rbase + ai * 128 + wr * 64 + m * 16 + fr) * DM + c; const pg8::f32x4 v0 = g0 * acc[ai][bj][m][0], v1 = g1 * acc[ai][bj][m][1]; u32x4 w; w.x = pk2(v0[0], v0[1]); w.y = pk2(v0[2], v0[3]); w.z = pk2(v1[0], v1[1]); w.w = pk2(v1[2], v1[3]); *(u32x4*)(tp + off) = w; } }
            return; }
#pragma unroll
        for (int bj = 0; bj < 2; ++bj) { const int c = col0 + bj * 128; const pg8::f32x4 g0 = *(const pg8::f32x4*)(gp + c), g1 = *(const pg8::f32x4*)(gp + c + 4);
#pragma unroll
            for (int ai = 0; ai < 2; ++ai)
#pragma unroll
                for (int m = 0; m < 4; ++m) { const size_t off = (size_t)(rbase + ai * 128 + wr * 64 + m * 16 + fr) * DM + c;
                    const pg8::f32x4 b0 = *(const pg8::f32x4*)(xb + off), b1 = *(const pg8::f32x4*)(xb + off + 4);
                    *(pg8::f32x4*)(xo + off) = b0 + g0 * acc[ai][bj][m][0]; *(pg8::f32x4*)(xo + off + 4) = b1 + g1 * acc[ai][bj][m][1]; } }
    }
};
struct EpiSwiglu {
    static constexpr bool PERM = true, AFTER_DRAIN = false;
    bf16* ACT;
    __device__ __forceinline__ void operator()(const pg8::f32x4 (&acc)[2][2][4][2], const pg8::Unit& u, int wr, int wc, int fr, int fq) const {
        const int row0 = u.pm * 256 + wr * 64 + fr, col = u.pn * 128 + wc * 32 + 8 * fq;
#pragma unroll
        for (int ai = 0; ai < 2; ++ai)
#pragma unroll
            for (int m = 0; m < 4; ++m) { float o[8];
#pragma unroll
                for (int n = 0; n < 2; ++n)
#pragma unroll
                    for (int e = 0; e < 4; ++e) { const float g = acc[ai][0][m][n][e], up = acc[ai][1][m][n][e]; o[4 * n + e] = silu_f(g) * up; }
                u32x4 w; w.x = pk2(o[0], o[1]); w.y = pk2(o[2], o[3]); w.z = pk2(o[4], o[5]); w.w = pk2(o[6], o[7]);
                *(u32x4*)(ACT + (size_t)(row0 + ai * 128 + m * 16) * FF + col) = w; }
    }
};
struct EpiFourier {
    static constexpr bool PERM = true, AFTER_DRAIN = false;
    bf16* MX; int rowbase, rpb; float scale;
    __device__ __forceinline__ void operator()(const pg8::f32x4 (&acc)[2][2][4][2], const pg8::Unit& u, int wr, int wc, int fr, int fq) const {
        const int k0 = u.pm * 256 + wr * 64 + fr, col0 = wc * 32 + 8 * fq;
#pragma unroll
        for (int ai = 0; ai < 2; ++ai)
#pragma unroll
            for (int m = 0; m < 4; ++m) { bf16* rowp = MX + (size_t)(rowbase + u.pn * rpb + k0 + ai * 128 + m * 16) * DM + col0;
#pragma unroll
                for (int bj = 0; bj < 2; ++bj) { const pg8::f32x4 v0 = acc[ai][bj][m][0] * scale, v1 = acc[ai][bj][m][1] * scale; u32x4 w; w.x = pk2(v0[0], v0[1]); w.y = pk2(v0[2], v0[3]); w.z = pk2(v1[0], v1[1]); w.w = pk2(v1[2], v1[3]);
                    *(u32x4*)(rowp + bj * 128) = w; } }
    }
};

#define XB_TMO      128
#define XB_XCNT(j)  (256  + 64 * (j))
#define XB_XSUB(j)  (1280 + 64 * (j))
#define XB_XGEN(j)  (2304 + 64 * (j))
#define XB_TOP      3328
#define XB_TOPGEN   3392
#define XCD_BAR_WORDS 3456
#define XB_SPIN_CAP (1u << 18)

__device__ __forceinline__ unsigned xb_ld(unsigned* p)              { return __hip_atomic_load(p, __ATOMIC_RELAXED, __HIP_MEMORY_SCOPE_AGENT); }
__device__ __forceinline__ unsigned xb_add(unsigned* p, unsigned v) { return __hip_atomic_fetch_add(p, v, __ATOMIC_RELAXED, __HIP_MEMORY_SCOPE_AGENT); }
__device__ __forceinline__ unsigned xb_xcc_id() { return (unsigned)__builtin_amdgcn_s_getreg((3 << 11) | 20) & 0xFu; }
#define XB_SPIN(cond, bar) do { unsigned _sp = 0; while (cond) { __builtin_amdgcn_s_sleep(1); \
    if ((++_sp & 255u) == 0u) { if (xb_ld(&(bar)[XB_TMO])) break; if (_sp > XB_SPIN_CAP) { atomicAdd(&(bar)[XB_TMO], 1u); break; } } } } while (0)

struct XcdBarrier {
    unsigned* bar; unsigned x;
    volatile LAS unsigned* st;
};

__device__ __forceinline__ XcdBarrier xcd_barrier_post(unsigned* bar, volatile LAS unsigned* st) {
    XcdBarrier b; b.bar = bar; b.x = xb_xcc_id(); b.st = st;
    if (threadIdx.x == 0) (void)xb_add(&bar[XB_XCNT(b.x)], 1u);
    return b;
}
__device__ __forceinline__ void xcd_barrier_complete(unsigned* bar, unsigned x, unsigned& nloc, unsigned& nx) {
    const unsigned G = gridDim.x * gridDim.y * gridDim.z;
    unsigned sum, cnt, mine, sp = 0u;
    for (;;) {
        sum = 0u; cnt = 0u; mine = 0u;
#pragma unroll
        for (unsigned j = 0; j < 16; ++j) { const unsigned c = xb_ld(&bar[XB_XCNT(j)]); sum += c; cnt += (c > 0u) ? 1u : 0u; mine = (j == x) ? c : mine; }
        if (sum == G) break;
        __builtin_amdgcn_s_sleep(1);
        if ((++sp & 255u) == 0u) { if (xb_ld(&bar[XB_TMO])) break; if (sp > XB_SPIN_CAP) { atomicAdd(&bar[XB_TMO], 1u); break; } }
    }
    nloc = mine > 0u ? mine : 1u; nx = cnt > 0u ? cnt : 1u;
}

__device__ __forceinline__ void xcd_barrier(const XcdBarrier& b) {
    asm volatile("s_waitcnt vmcnt(0)" ::: "memory");
    __syncthreads();
    if (threadIdx.x == 0) {
        unsigned* bar = b.bar;
        __builtin_amdgcn_s_waitcnt(0);
        unsigned nloc = b.st[0], nx = b.st[1];
        if (nloc == 0u) { xcd_barrier_complete(bar, b.x, nloc, nx); b.st[0] = nloc; b.st[1] = nx; }
        const unsigned old = xb_add(&bar[XB_XSUB(b.x)], 1u);
        const unsigned gen = old / nloc;
        if (old + 1u == (gen + 1u) * nloc) {
            __builtin_amdgcn_fence(__ATOMIC_RELEASE, "agent");
            asm volatile("s_waitcnt vmcnt(0)" ::: "memory");
            const unsigned og = xb_add(&bar[XB_TOP], 1u);
            const unsigned tg = og / nx;
            if (og + 1u == (tg + 1u) * nx) xb_add(&bar[XB_TOPGEN], 1u);
            else XB_SPIN(xb_ld(&bar[XB_TOPGEN]) == tg, bar);
            __builtin_amdgcn_fence(__ATOMIC_ACQUIRE, "agent");
            xb_add(&bar[XB_XGEN(b.x)], 1u);
            asm volatile("s_waitcnt vmcnt(0)" ::: "memory");
        } else {
            XB_SPIN(xb_ld(&bar[XB_XGEN(b.x)]) == gen, bar);
            __builtin_amdgcn_fence(__ATOMIC_ACQUIRE, "agent");
            asm volatile("s_waitcnt vmcnt(0)" ::: "memory");
        }
    }
    __syncthreads();
}

__device__ __forceinline__ const float* ldptr(LAS unsigned char* L, int i) {
    const LAS unsigned* p = (const LAS unsigned*)(L + 131072) + 2 * i;
    const unsigned lo = __builtin_amdgcn_readfirstlane(p[0]), hi = __builtin_amdgcn_readfirstlane(p[1]);
    return (const float*)(((unsigned long long)hi << 32) | (unsigned long long)lo);
}
#define INP(i) ldptr(L, (i))
#define OUTP ((float*)ldptr(L, 27))
#define WSP ((unsigned char*)ldptr(L, 28))
__device__ __forceinline__ void tr_item(const float* W, int ldw, int K, int ncb, bf16* WT, int row_off, int mode, const float* gk, LAS float* scr, int item, int lane) {
    const int kb = item / ncb, nb = item % ncb, k0 = 64 * kb, n0 = 32 * nb;
    { const int kq = lane >> 3, nq = lane & 7; f32x4 v[8];
#pragma unroll
      for (int i = 0; i < 8; ++i) v[i] = *(const f32x4*)(W + (size_t)(k0 + 8 * i + kq) * ldw + n0 + 4 * nq);
#pragma unroll
      for (int i = 0; i < 8; ++i) { const int kk = 8 * i + kq; const float gv = gk ? gk[k0 + kk] : 1.0f; LAS float* d = scr + kk * 33 + 4 * nq; d[0] = v[i].x * gv; d[1] = v[i].y * gv; d[2] = v[i].z * gv; d[3] = v[i].w * gv; } }
    LDS_WAIT();
    const int c = lane & 7;
#pragma unroll
    for (int j = 0; j < 4; ++j) { const int n = (lane >> 3) + 8 * j; const LAS float* s = scr + (8 * c) * 33 + n;
        u32x4 o; o.x = pk2(s[0 * 33], s[1 * 33]); o.y = pk2(s[2 * 33], s[3 * 33]); o.z = pk2(s[4 * 33], s[5 * 33]); o.w = pk2(s[6 * 33], s[7 * 33]);
        const int nn = n0 + n; int dr = nn;
        if (mode == 1) dr = nn < FF ? ((nn >> 7) * 256 + (nn & 127)) : ((((nn - FF) >> 7) * 256) + 128 + ((nn - FF) & 127));
        *(u32x4*)(WT + (size_t)(row_off + dr) * K + k0 + 8 * c) = o; }
    LDS_WAIT();
}

__device__ __forceinline__ void prologue(LAS unsigned char* L, int tid, int wave, int lane) {
    unsigned char* ws = WSP;
    LAS float* tab = (LAS float*)L;
    LAS float* sv = (LAS float*)(L + 8192);
    LAS float* red = (LAS float*)(L + 45056);
    const int G = gridDim.x, bid = blockIdx.x;
    const size_t gtid_all = (size_t)bid * 512 + tid, NT_all = (size_t)G * 512;
    LAS float* c64 = (LAS float*)(L + 81920); LAS float* s64 = c64 + 64;
    for (int i = tid; i < 2048; i += 512) tab[i] = cospif((float)i * (1.0f / 1024.0f));
    if (tid < 64) { c64[tid] = cospif((float)tid * (1.0f / 32.0f)); s64[tid] = -sinpif((float)tid * (1.0f / 32.0f)); }
    for (int i = tid; i < 9216; i += 512) { const int r = i >> 10, k = i & 1023; const float v = r < 8 ? INP(1)[r * 1024 + k] : INP(3)[k]; sv[i] = silu_f(v); }
    __syncthreads();
    float* MOD = (float*)(ws + WS_MOD);
    for (int it = bid; it < 256; it += G) {
        const int l = it >> 6, col0 = (it & 63) * 96, col = col0 + 2 * (lane < 48 ? lane : 0);
        const float* wp = INP(4) + ((size_t)l * 1024 + wave * 128) * 6144 + col;
        float acc[9][2];
#pragma unroll
        for (int r = 0; r < 9; ++r) { acc[r][0] = 0.f; acc[r][1] = 0.f; }
#pragma unroll 8
        for (int k = 0; k < 128; ++k) { const f32x2 w = *(const f32x2*)(wp + (size_t)k * 6144);
#pragma unroll
            for (int r = 0; r < 9; ++r) { const float s = sv[r * 1024 + wave * 128 + k]; acc[r][0] += s * w.x; acc[r][1] += s * w.y; } }
#pragma unroll
        for (int r = 0; r < 9; ++r) { red[(wave * 9 + r) * 128 + 2 * lane] = acc[r][0]; red[(wave * 9 + r) * 128 + 2 * lane + 1] = acc[r][1]; }
        __syncthreads();
        for (int i = tid; i < 864; i += 512) { const int r = i / 96, cc = i % 96; float s = 0.f;
#pragma unroll
            for (int w = 0; w < 8; ++w) s += red[(w * 9 + r) * 128 + cc];
            MOD[((size_t)l * 9 + r) * 6144 + col0 + cc] = s + INP(5)[l * 6144 + col0 + cc]; }
        __syncthreads();
    }
    bf16* WOD = (bf16*)(ws + WS_WOD);
    const bool cvt_all = true; const size_t gtid = cvt_all ? gtid_all : (bid >= 192 ? (size_t)(bid - 192) * 512 + tid : (size_t)1 << 40); const size_t NT = cvt_all ? NT_all : (size_t)(G - 192) * 512;
    for (size_t idx = gtid; idx < (size_t)2 * 512 * 1024; idx += NT) {
        const int m = (int)idx & 63, kk = ((int)idx >> 6) & 1023, rest = (int)(idx >> 16), g = rest & 3, part = (rest >> 2) & 1, i = rest >> 3;
        const float* src = INP(20) + ((size_t)i * 1024 + kk) * 960 + g * 64; float acc = 0.f;
        const LAS float* tw64 = part ? s64 : c64;
        for (int c = 0; c < 64; ++c) { const int j = (m * c) & 63; acc += tw64[j] * src[c]; }
        WOD[((size_t)i * ODP + part * 256 + g * 64 + m) * 1024 + kk] = (bf16)f2bf(acc);
    }
    { bf16* SGW = (bf16*)(ws + WS_SGW); for (size_t idx = gtid; idx < 131072; idx += NT) SGW[idx] = (bf16)f2bf(INP(18)[idx]); }
    { bf16* DX = (bf16*)(ws + WS_DFTX);
      for (size_t idx = gtid; idx < (size_t)2048 * 512; idx += NT) { const int k = (int)(idx >> 9), t8 = ((int)idx & 511) * 8; float v[8];
#pragma unroll
          for (int e = 0; e < 8; ++e) { const int tp = t8 + e; v[e] = tp < 2048 ? tab[(k * tp) & 2047] : tab[(k * (tp - 2048) - 512) & 2047]; }
          u32x4 o; o.x = pk2(v[0], v[1]); o.y = pk2(v[2], v[3]); o.z = pk2(v[4], v[5]); o.w = pk2(v[6], v[7]); *(u32x4*)(DX + (size_t)k * 4096 + t8) = o; } }
    { bf16* DC = (bf16*)(ws + WS_DFTC);
      for (size_t idx = gtid; idx < (size_t)256 * 64; idx += NT) { const int k = (int)(idx >> 6), t8 = ((int)idx & 63) * 8; float v[8];
#pragma unroll
          for (int e = 0; e < 8; ++e) { const int tp = t8 + e; v[e] = tp < 256 ? tab[((k * tp) & 255) * 8] : tab[(((k * (tp - 256)) & 255) * 8 - 512) & 2047]; }
          u32x4 o; o.x = pk2(v[0], v[1]); o.y = pk2(v[2], v[3]); o.z = pk2(v[4], v[5]); o.w = pk2(v[6], v[7]); *(u32x4*)(DC + (size_t)k * 512 + t8) = o; } }
    { const u32x4 z = {0u, 0u, 0u, 0u};
      for (size_t idx = gtid; idx < (size_t)2 * 28672; idx += NT) { const int i = (int)(idx / 28672), r = (int)(idx % 28672); *(u32x4*)((bf16*)(ws + WS_WEV) + ((size_t)i * EVP + EVW) * 1024 + (size_t)r * 8) = z; }
      for (size_t idx = gtid; idx < (size_t)2 * 8192; idx += NT) { const int i = (int)(idx / 8192), r = (int)(idx % 8192); *(u32x4*)(WOD + ((size_t)i * ODP + 1216) * 1024 + (size_t)r * 8) = z; }
      for (size_t idx = gtid; idx < (size_t)2 * 6144; idx += NT) { const int i = (int)(idx / 6144), r = (int)(idx % 6144); *(u32x4*)((bf16*)(ws + WS_WUQ) + ((size_t)i * 1280 + 1152) * 384 + (size_t)r * 8) = z; } }
    __syncthreads();
    LAS float* scr = (LAS float*)(L + 45056 + wave * 8448);
    const int gw = bid * 8 + wave, NGW = G * 8;
    constexpr int I_EV = 16 * 81, I_OD = 16 * 22, I_UQ = 6 * 36, I_UKV = 4 * 48, I_MIX = 16 * 32, I_FI = 16 * 176, I_FO = 44 * 32;
    constexpr int NITEMS = 2 * (I_EV + I_OD + I_UQ + I_UKV) + 4 * (I_MIX + I_FI + I_FO);
    for (int it = gw; it < NITEMS; it += NGW) {
        int r = it;
        if (r < 4 * I_FI) { const int l = r / I_FI; tr_item(INP(9) + (size_t)l * 1024 * 5632, 5632, 1024, 176, (bf16*)(ws + WS_WFI) + (size_t)l * 5632 * 1024, 0, 1, nullptr, scr, r % I_FI, lane); continue; } r -= 4 * I_FI;
        if (r < 4 * I_FO) { const int l = r / I_FO; tr_item(INP(10) + (size_t)l * 2816 * 1024, 1024, 2816, 32, (bf16*)(ws + WS_WFO) + (size_t)l * 1024 * 2816, 0, 0, nullptr, scr, r % I_FO, lane); continue; } r -= 4 * I_FO;
        if (r < 4 * I_MIX) { const int l = r / I_MIX; tr_item(INP(8) + (size_t)l * 1024 * 1024, 1024, 1024, 32, (bf16*)(ws + WS_WMIX) + (size_t)l * 1024 * 1024, 0, 0, nullptr, scr, r % I_MIX, lane); continue; } r -= 4 * I_MIX;
        if (r < 2 * I_EV) { const int i = r / I_EV; tr_item(INP(11) + (size_t)i * 1024 * EVW, EVW, 1024, 81, (bf16*)(ws + WS_WEV) + (size_t)i * EVP * 1024, 0, 0, nullptr, scr, r % I_EV, lane); continue; } r -= 2 * I_EV;
        if (r < 2 * I_OD) { const int i = r / I_OD; tr_item(INP(20) + (size_t)i * 1024 * 960 + 256, 960, 1024, 22, WOD + (size_t)i * ODP * 1024, 512, 0, nullptr, scr, r % I_OD, lane); continue; } r -= 2 * I_OD;
        if (r < 2 * I_UQ) { const int i = r / I_UQ; tr_item(INP(22) + (size_t)i * 384 * 1152, 1152, 384, 36, (bf16*)(ws + WS_WUQ) + (size_t)i * 1280 * 384, 0, 0, INP(21) + i * 384, scr, r % I_UQ, lane); continue; } r -= 2 * I_UQ;
        { const int i = r / I_UKV; tr_item(INP(24) + (size_t)i * 256 * 1536, 1536, 256, 48, (bf16*)(ws + WS_WUKV) + (size_t)i * 1536 * 256, 0, 0, INP(23) + i * 256, scr, r % I_UKV, lane); }
    }
}

__device__ __forceinline__ void norm_phase(const float* xin, const float* hin, const float* gvec, const float* mod, int shift_idx, int scale_idx, bf16* Z, int ntok, int wave, int lane, const bf16* T, float* hout) {
    constexpr int NR = 3;
    const int gw = blockIdx.x * 8 + wave, NGW = gridDim.x * 8;
    f32x4 gg[4];
#pragma unroll
    for (int j = 0; j < 4; ++j) gg[j] = *(const f32x4*)(gvec + 4 * lane + 256 * j);
    for (int rb = gw; rb < ntok; rb += NR * NGW) {
        f32x4 v[NR][4];
#pragma unroll
        for (int q = 0; q < NR; ++q) { const int row = (rb + q * NGW < ntok) ? rb + q * NGW : rb; const float* src = row < NTX ? xin + (size_t)row * DM : hin + (size_t)(row - NTX) * DM;
#pragma unroll
            for (int j = 0; j < 4; ++j) v[q][j] = *(const f32x4*)(src + 4 * lane + 256 * j); }
        if (T && rb + (NR - 1) * NGW >= NTX) {
#pragma unroll
            for (int q = 0; q < NR; ++q) { const int row = rb + q * NGW; if (row >= NTX && row < ntok) {
#pragma unroll
                for (int sp = 0; sp < 8; ++sp)
#pragma unroll
                    for (int j = 0; j < 4; ++j) { const u32x2 w = *(const u32x2*)(T + ((size_t)sp * 2048 + (row - NTX)) * DM + 4 * lane + 256 * j); v[q][j] += (f32x4){bflo(w.x), bfhi(w.x), bflo(w.y), bfhi(w.y)}; }
#pragma unroll
                for (int j = 0; j < 4; ++j) *(f32x4*)(hout + (size_t)(row - NTX) * DM + 4 * lane + 256 * j) = v[q][j]; } }
        }
        float ss[NR];
#pragma unroll
        for (int q = 0; q < NR; ++q) { float s = 0.f;
#pragma unroll
            for (int j = 0; j < 4; ++j) s += (v[q][j].x * v[q][j].x + v[q][j].y * v[q][j].y) + (v[q][j].z * v[q][j].z + v[q][j].w * v[q][j].w);
            ss[q] = s; }
#pragma unroll
        for (int o = 1; o < 64; o <<= 1)
#pragma unroll
            for (int q = 0; q < NR; ++q) ss[q] += __shfl_xor(ss[q], o);
#pragma unroll
        for (int q = 0; q < NR; ++q) { const int row = rb + q * NGW; if (row < ntok) {
            const float rstd = rsqrtf(ss[q] * (1.f / DM) + EPS); const int mr = row < NTX ? (row >> 11) : 8; const float* mp = mod + (size_t)mr * 6144;
#pragma unroll
            for (int j = 0; j < 4; ++j) { const int c = 4 * lane + 256 * j; const f32x4 sc = *(const f32x4*)(mp + scale_idx * 1024 + c), sh = *(const f32x4*)(mp + shift_idx * 1024 + c);
                const f32x4 z = v[q][j] * rstd * gg[j] * (sc + 1.0f) + sh; u32x2 o; o.x = pk2(z.x, z.y); o.y = pk2(z.z, z.w); *(u32x2*)(Z + (size_t)row * DM + c) = o; } } }
    }
}

__device__ __forceinline__ int gla_tok0(int b, int c) { return c < 4 ? NTX + b * 256 + 64 * c : b * 2048 + 64 * (c - 4); }
__device__ __forceinline__ int gla_uidx(int dir, int b, int h, int c) { return ((dir * 8 + b) * 4 + h) * 36 + c; }
__device__ __forceinline__ void gla_gates(const LAS bf16* A32, const float (&wf)[16], const float (&wb)[16], float bf0, float bb0, LAS float* Gf, LAS float* Gb, LAS float* TOT, int tid) {
    const int k = tid & 63;
#pragma unroll 2
    for (int i = 0; i < 8; ++i) { const int p = (tid >> 6) + 8 * i; const LAS u32x4* ap = (const LAS u32x4*)(A32 + p * 32);
        const u32x4 a0 = ap[0], a1 = ap[1], b0 = ap[2], b1 = ap[3];
        float yf = bf0, yb = bb0;
#pragma unroll
        for (int w = 0; w < 4; ++w) { yf += bflo(a0[w]) * wf[2 * w] + bfhi(a0[w]) * wf[2 * w + 1]; yf += bflo(a1[w]) * wf[8 + 2 * w] + bfhi(a1[w]) * wf[9 + 2 * w];
                                      yb += bflo(b0[w]) * wb[2 * w] + bfhi(b0[w]) * wb[2 * w + 1]; yb += bflo(b1[w]) * wb[8 + 2 * w] + bfhi(b1[w]) * wb[9 + 2 * w]; }
        Gf[p * 64 + k] = logsig_f(yf) * 0.0625f; Gb[p * 64 + k] = logsig_f(yb) * 0.0625f; }
    __syncthreads();
    {
        const int dir = tid >> 8, seg = (tid >> 6) & 3; LAS float* arr = dir ? Gb : Gf; float a[16];
#pragma unroll
        for (int j = 0; j < 16; ++j) a[j] = arr[(16 * seg + j) * 64 + k];
        if (!dir) {
#pragma unroll
            for (int j = 1; j < 16; ++j) a[j] += a[j - 1];
            TOT[(dir * 4 + seg) * 64 + k] = a[15]; }
        else {
#pragma unroll
            for (int j = 14; j >= 0; --j) a[j] += a[j + 1];
            TOT[(dir * 4 + seg) * 64 + k] = a[0]; }
        __syncthreads();
        float off = 0.f;
#pragma unroll
        for (int s2 = 0; s2 < 4; ++s2) { const float t = TOT[(dir * 4 + s2) * 64 + k]; if (dir ? (s2 > seg) : (s2 < seg)) off += t; }
#pragma unroll
        for (int j = 0; j < 16; ++j) arr[(16 * seg + j) * 64 + k] = a[j] + off;
    }
    __syncthreads();
}
__device__ __forceinline__ void gla_passA(int unit, const bf16* P, const float* waf, const float* baf, const float* wab, const float* bab, bf16* U, float* DD, LAS unsigned char* L, int tid, int wave, int lane) {
    const int b = unit / 144, rem = unit % 144, h = rem / 36, c = rem % 36, tok0 = gla_tok0(b, c);
    LAS float* Gf = (LAS float*)L; LAS float* Gb = (LAS float*)(L + 16384);
    LAS bf16* KDf = (LAS bf16*)(L + 32768); LAS bf16* KDb = (LAS bf16*)(L + 32768 + 9216); LAS bf16* Vs = (LAS bf16*)(L + 32768 + 18432); LAS bf16* A32 = (LAS bf16*)(L + 32768 + 18432 + 18432);
    const int k = tid & 63, rpos = tid >> 3, rk8 = (tid & 7) * 8;
    u32x4 a32 = {0u, 0u, 0u, 0u}; if (tid < 256) a32 = *(const u32x4*)(P + (size_t)(tok0 + (tid >> 2)) * EVW + 1536 + (tid & 3) * 8);
    float wf[16], wb[16];
#pragma unroll
    for (int r = 0; r < 16; ++r) { wf[r] = waf[r * 256 + h * 64 + k]; wb[r] = wab[r * 256 + h * 64 + k]; }
    const float bf0 = baf[h * 64 + k], bb0 = bab[h * 64 + k];
    const u32x4 kraw = *(const u32x4*)(P + (size_t)(tok0 + rpos) * EVW + 256 + h * 64 + rk8);
    u32x4 vraw[2];
#pragma unroll
    for (int i = 0; i < 2; ++i) { const int q = tid + 512 * i; vraw[i] = *(const u32x4*)(P + (size_t)(tok0 + (q >> 4)) * EVW + 512 + h * 128 + (q & 15) * 8); }
    if (tid < 256) *(LAS u32x4*)(A32 + (tid >> 2) * 32 + (tid & 3) * 8) = a32;
#pragma unroll
    for (int i = 0; i < 2; ++i) { const int q = tid + 512 * i; *(LAS u32x4*)(Vs + (q >> 4) * 144 + (q & 15) * 8) = vraw[i]; }
    __syncthreads();
    gla_gates(A32, wf, wb, bf0, bb0, Gf, Gb, (LAS float*)((LAS unsigned char*)A32 + 4096), tid);
    {
        float kv[8];
#pragma unroll
        for (int w = 0; w < 4; ++w) { kv[2 * w] = bflo(kraw[w]); kv[2 * w + 1] = bfhi(kraw[w]); }
        u32x4 of, ob;
#pragma unroll
        for (int w = 0; w < 4; ++w) { const int k0 = rk8 + 2 * w;
            const float f0 = kv[2 * w] * __expf(Gf[63 * 64 + k0] - Gf[rpos * 64 + k0]), f1 = kv[2 * w + 1] * __expf(Gf[63 * 64 + k0 + 1] - Gf[rpos * 64 + k0 + 1]);
            const float g0 = kv[2 * w] * __expf(Gb[k0] - Gb[rpos * 64 + k0]), g1 = kv[2 * w + 1] * __expf(Gb[k0 + 1] - Gb[rpos * 64 + k0 + 1]);
            of[w] = pk2(f0, f1); ob[w] = pk2(g0, g1); }
        *(LAS u32x4*)(KDf + rpos * 72 + rk8) = of; *(LAS u32x4*)(KDb + rpos * 72 + rk8) = ob;
    }
    if (tid < 64) DD[(size_t)gla_uidx(0, b, h, c) * 64 + tid] = __expf(Gf[63 * 64 + tid]);
    else if (tid < 128) DD[(size_t)gla_uidx(1, b, h, c) * 64 + (tid - 64)] = __expf(Gb[tid - 64]);
    __syncthreads();
    const int g = lane >> 4, i15 = lane & 15, q4 = i15 >> 2, pp = i15 & 3, dv0 = 16 * wave;
    bf16x8 Af[2];
#pragma unroll
    for (int ks = 0; ks < 2; ++ks) { const LAS unsigned char* p1 = (const LAS unsigned char*)Vs + (32 * ks + 8 * g + q4) * 288 + (dv0 + 4 * pp) * 2; Af[ks] = tr2(p1, p1 + 4 * 288); }
#pragma unroll
    for (int dir = 0; dir < 2; ++dir) { const LAS unsigned char* KD = (const LAS unsigned char*)(dir ? KDb : KDf); bf16* up = U + (size_t)gla_uidx(dir, b, h, c) * 8192;
#pragma unroll
        for (int kt = 0; kt < 4; ++kt) { f32x4 acc = {0.f, 0.f, 0.f, 0.f};
#pragma unroll
            for (int ks = 0; ks < 2; ++ks) { const LAS unsigned char* p1 = KD + (32 * ks + 8 * g + q4) * 144 + (16 * kt + 4 * pp) * 2; const bf16x8 Bf = tr2(p1, p1 + 4 * 144); acc = MFMA16(Af[ks], Bf, acc); }
#pragma unroll
            for (int r = 0; r < 4; ++r) up[(dv0 + 4 * g + r) * 64 + 16 * kt + i15] = (bf16)f2bf(acc[r]); } }
    __syncthreads();
}
__device__ __forceinline__ void gla_passB(const bf16* U, const float* DD, bf16* SB, int tid) {
    const size_t NT = (size_t)gridDim.x * 512;
    for (size_t gid = (size_t)blockIdx.x * 512 + tid; gid < (size_t)64 * 2048; gid += NT) {
        const int e4 = (int)gid & 2047, seq = (int)(gid >> 11), dir = seq >> 5, bh = seq & 31, kq = (e4 * 4) & 63;
        f32x4 S = {0.f, 0.f, 0.f, 0.f};
        for (int s0 = 0; s0 < 36; s0 += 6) { f32x4 dd[6], uu[6]; size_t ui[6];
#pragma unroll
            for (int j = 0; j < 6; ++j) { const int step = s0 + j, c = dir ? (step < 4 ? 3 - step : 39 - step) : step; ui[j] = (size_t)(dir * 32 + bh) * 36 + c;
                dd[j] = *(const f32x4*)(DD + ui[j] * 64 + kq); { const u32x2 w = *(const u32x2*)(U + ui[j] * 8192 + (size_t)e4 * 4); uu[j] = (f32x4){bflo(w.x), bfhi(w.x), bflo(w.y), bfhi(w.y)}; } }
#pragma unroll
            for (int j = 0; j < 6; ++j) { u32x2 o; o.x = pk2(S.x, S.y); o.y = pk2(S.z, S.w); *(u32x2*)(SB + ui[j] * 8192 + (size_t)e4 * 4) = o; S = dd[j] * S + uu[j]; } }
    }
}
struct GlaPre { u32x4 a32, qraw, kraw, v0, v1; f32x4 wf4[4], wb4[4]; float bf0, bb0; };
__device__ __forceinline__ GlaPre gla_pre_load(int unit, const bf16* P, const float* waf, const float* baf, const float* wab, const float* bab, int tid) {
    const int b = unit / 144, rem = unit % 144, h = rem / 36, c = rem % 36, tok0 = gla_tok0(b, c);
    const int k = tid & 63, rpos = tid >> 3, rk8 = (tid & 7) * 8;
    GlaPre r;
    r.a32 = (u32x4){0u, 0u, 0u, 0u}; if (tid < 256) r.a32 = *(const u32x4*)(P + (size_t)(tok0 + (tid >> 2)) * EVW + 1536 + (tid & 3) * 8);
#pragma unroll
    for (int q = 0; q < 4; ++q)
#pragma unroll
        for (int e = 0; e < 4; ++e) { r.wf4[q][e] = waf[(4 * q + e) * 256 + h * 64 + k]; r.wb4[q][e] = wab[(4 * q + e) * 256 + h * 64 + k]; }
    r.bf0 = baf[h * 64 + k]; r.bb0 = bab[h * 64 + k];
    r.qraw = *(const u32x4*)(P + (size_t)(tok0 + rpos) * EVW + h * 64 + rk8); r.kraw = *(const u32x4*)(P + (size_t)(tok0 + rpos) * EVW + 256 + h * 64 + rk8);
    r.v0 = *(const u32x4*)(P + (size_t)(tok0 + (tid >> 4)) * EVW + 512 + h * 128 + (tid & 15) * 8);
    r.v1 = *(const u32x4*)(P + (size_t)(tok0 + ((tid + 512) >> 4)) * EVW + 512 + h * 128 + (tid & 15) * 8);
    return r;
}
__device__ __forceinline__ void gla_passC(int unit, const GlaPre& pre, const bf16* P, const bf16* SB, const float* onorm, bf16* MX, LAS unsigned char* L, int tid, int wave, int lane) {
    const int b = unit / 144, rem = unit % 144, h = rem / 36, c = rem % 36, tok0 = gla_tok0(b, c);
    LAS float* Gf = (LAS float*)L; LAS float* Gb = (LAS float*)(L + 16384); LAS float* Os = (LAS float*)L;
    LAS bf16* QF = (LAS bf16*)(L + 32768); LAS bf16* KF = (LAS bf16*)(L + 32768 + 9216); LAS bf16* QB = (LAS bf16*)(L + 32768 + 2 * 9216); LAS bf16* KB = (LAS bf16*)(L + 32768 + 3 * 9216);
    LAS bf16* Vs = (LAS bf16*)(L + 69632); LAS bf16* AS = (LAS bf16*)(L + 88064); LAS bf16* A32 = (LAS bf16*)(L + 98304);
    const int k = tid & 63, rpos = tid >> 3, rk8 = (tid & 7) * 8;
    const int g = lane >> 4, i15 = lane & 15, q4 = i15 >> 2, pp = i15 & 3, t0 = 16 * (wave & 3), dvb = 64 * (wave >> 2);
    const u32x4 a32 = pre.a32, qraw = pre.qraw, kraw = pre.kraw; u32x4 vraw[2] = {pre.v0, pre.v1};
    float wf[16], wb[16];
#pragma unroll
    for (int r = 0; r < 16; ++r) { wf[r] = pre.wf4[r >> 2][r & 3]; wb[r] = pre.wb4[r >> 2][r & 3]; }
    const float bf0 = pre.bf0, bb0 = pre.bb0;
    const bf16* gp = P + (size_t)(tok0 + rpos) * EVW + 1024 + h * 128 + (tid & 7) * 16; const u32x4 g0 = *(const u32x4*)gp, g1 = *(const u32x4*)(gp + 8);
    const bf16* sbf = SB + (size_t)gla_uidx(0, b, h, c) * 8192; const bf16* sbb = SB + (size_t)gla_uidx(1, b, h, c) * 8192;
    bf16x8 Bsf[4][2], Bsb[4][2];
#pragma unroll
    for (int dt = 0; dt < 4; ++dt)
#pragma unroll
        for (int ks = 0; ks < 2; ++ks) { Bsf[dt][ks] = *(const bf16x8*)(sbf + (dvb + 16 * dt + i15) * 64 + 32 * ks + 8 * g); Bsb[dt][ks] = *(const bf16x8*)(sbb + (dvb + 16 * dt + i15) * 64 + 32 * ks + 8 * g); }
    if (tid < 256) *(LAS u32x4*)(A32 + (tid >> 2) * 32 + (tid & 3) * 8) = a32;
#pragma unroll
    for (int i = 0; i < 2; ++i) { const int q = tid + 512 * i; *(LAS u32x4*)(Vs + (q >> 4) * 144 + (q & 15) * 8) = vraw[i]; }
    __syncthreads();
    gla_gates(A32, wf, wb, bf0, bb0, Gf, Gb, (LAS float*)((LAS unsigned char*)A32 + 4096), tid);
    {
        u32x4 oqf, okf, oqb, okb;
#pragma unroll
        for (int w = 0; w < 4; ++w) { const int k0 = rk8 + 2 * w;
            const float q0 = bflo(qraw[w]) * 0.125f, q1 = bfhi(qraw[w]) * 0.125f, k0v = bflo(kraw[w]), k1v = bfhi(kraw[w]);
            const float gf0 = Gf[rpos * 64 + k0], gf1 = Gf[rpos * 64 + k0 + 1], gb0 = Gb[rpos * 64 + k0], gb1 = Gb[rpos * 64 + k0 + 1];
            oqf[w] = pk2(q0 * __expf(gf0), q1 * __expf(gf1)); okf[w] = pk2(k0v * __expf(-gf0), k1v * __expf(-gf1));
            oqb[w] = pk2(q0 * __expf(gb0), q1 * __expf(gb1)); okb[w] = pk2(k0v * __expf(-gb0), k1v * __expf(-gb1)); }
        *(LAS u32x4*)(QF + rpos * 72 + rk8) = oqf; *(LAS u32x4*)(KF + rpos * 72 + rk8) = okf; *(LAS u32x4*)(QB + rpos * 72 + rk8) = oqb; *(LAS u32x4*)(KB + rpos * 72 + rk8) = okb;
    }
    __syncthreads();
    {
        const int sb = 32 * (wave >> 2);
        bf16x8 Aqf[2], Aqb[2];
#pragma unroll
        for (int ks = 0; ks < 2; ++ks) { Aqf[ks] = *(const LAS bf16x8*)(QF + (t0 + i15) * 72 + 32 * ks + 8 * g); Aqb[ks] = *(const LAS bf16x8*)(QB + (t0 + i15) * 72 + 32 * ks + 8 * g); }
#pragma unroll
        for (int st = 0; st < 2; ++st) { const int s0 = sb + 16 * st; f32x4 af = {0.f, 0.f, 0.f, 0.f}, ab = {0.f, 0.f, 0.f, 0.f};
#pragma unroll
            for (int ks = 0; ks < 2; ++ks) { const bf16x8 Bf = *(const LAS bf16x8*)(KF + (s0 + i15) * 72 + 32 * ks + 8 * g), Bb = *(const LAS bf16x8*)(KB + (s0 + i15) * 72 + 32 * ks + 8 * g);
                af = MFMA16(Aqf[ks], Bf, af); ab = MFMA16(Aqb[ks], Bb, ab); }
#pragma unroll
            for (int r = 0; r < 4; ++r) { const int t = t0 + 4 * g + r, s = s0 + i15; const float v = (s <= t ? af[r] : 0.f) + (s >= t ? ab[r] : 0.f); AS[t * 72 + s] = (bf16)f2bf(v); } }
    }
    __syncthreads();
    {
        bf16x8 Aa[2], Aqf[2], Aqb[2];
#pragma unroll
        for (int ks = 0; ks < 2; ++ks) { Aa[ks] = *(const LAS bf16x8*)(AS + (t0 + i15) * 72 + 32 * ks + 8 * g); Aqf[ks] = *(const LAS bf16x8*)(QF + (t0 + i15) * 72 + 32 * ks + 8 * g); Aqb[ks] = *(const LAS bf16x8*)(QB + (t0 + i15) * 72 + 32 * ks + 8 * g); }
#pragma unroll
        for (int dt = 0; dt < 4; ++dt) { const int dv0 = dvb + 16 * dt; f32x4 acc = {0.f, 0.f, 0.f, 0.f};
#pragma unroll
            for (int ks = 0; ks < 2; ++ks) { const LAS unsigned char* p1 = (const LAS unsigned char*)Vs + (32 * ks + 8 * g + q4) * 288 + (dv0 + 4 * pp) * 2; const bf16x8 Bv = tr2(p1, p1 + 4 * 288); acc = MFMA16(Aa[ks], Bv, acc);
                acc = MFMA16(Aqf[ks], Bsf[dt][ks], acc); acc = MFMA16(Aqb[ks], Bsb[dt][ks], acc); }
#pragma unroll
            for (int r = 0; r < 4; ++r) Os[(t0 + 4 * g + r) * 128 + dv0 + i15] = acc[r]; }
    }
    __syncthreads();
    {
        const int t = rpos, d0 = (tid & 7) * 16; float o[16]; float ss = 0.f;
#pragma unroll
        for (int j = 0; j < 16; ++j) { o[j] = Os[t * 128 + d0 + j]; ss += o[j] * o[j]; }
        ss += __shfl_xor(ss, 1); ss += __shfl_xor(ss, 2); ss += __shfl_xor(ss, 4);
        const float r = rsqrtf(ss * (1.f / 128.f) + EPS);
        float gv[16];
#pragma unroll
        for (int w = 0; w < 4; ++w) { gv[2 * w] = bflo(g0[w]); gv[2 * w + 1] = bfhi(g0[w]); gv[8 + 2 * w] = bflo(g1[w]); gv[9 + 2 * w] = bfhi(g1[w]); }
#pragma unroll
        for (int j = 0; j < 16; ++j) o[j] = o[j] * r * onorm[d0 + j] * silu_f(gv[j]);
        u32x4 w0, w1; w0.x = pk2(o[0], o[1]); w0.y = pk2(o[2], o[3]); w0.z = pk2(o[4], o[5]); w0.w = pk2(o[6], o[7]); w1.x = pk2(o[8], o[9]); w1.y = pk2(o[10], o[11]); w1.z = pk2(o[12], o[13]); w1.w = pk2(o[14], o[15]);
        bf16* dst = MX + (size_t)(tok0 + t) * DM + h * 128 + d0; *(u32x4*)dst = w0; *(u32x4*)(dst + 8) = w1;
    }
    __syncthreads();
}

__device__ __forceinline__ void sg_unit(int unit, const bf16* P, const float* vng, const bf16* SGW, const float* bs, bf16* MX, LAS unsigned char* L, int tid, int wave, int lane) {
    const int g4 = unit & 3; int tok0;
    if (unit < 512) { const int b = unit >> 6, j = (unit >> 2) & 15; tok0 = b * 2048 + 128 * j; } else { const int u2 = unit - 512, b = u2 >> 3, j = (u2 >> 2) & 1; tok0 = NTX + b * 256 + 128 * j; }
    LAS bf16* VN = (LAS bf16*)L;
    const int g = lane >> 4, i15 = lane & 15, q4 = i15 >> 2, pp = i15 & 3, t0 = 16 * wave;
    bf16x8 Aw[4];
#pragma unroll
    for (int ks = 0; ks < 4; ++ks) Aw[ks] = *(const bf16x8*)(SGW + ((size_t)g4 * 128 + t0 + i15) * 128 + 32 * ks + 8 * g);
    float bsv[4];
#pragma unroll
    for (int r = 0; r < 4; ++r) bsv[r] = bs[g4 * 128 + t0 + 4 * g + r];
    bf16 uraw[8][4];
    { const int g_ = lane >> 4, i15_ = lane & 15;
#pragma unroll
      for (int ct = 0; ct < 8; ++ct)
#pragma unroll
        for (int r = 0; r < 4; ++r) uraw[ct][r] = P[(size_t)(tok0 + 16 * wave + 4 * g_ + r) * EVW + 1568 + g4 * 128 + 16 * ct + i15_]; }
    {   const int pos = tid >> 2, part = tid & 3; const bf16* sp = P + (size_t)(tok0 + pos) * EVW + 2080 + g4 * 128 + part * 32;
        float x[32]; float ss = 0.f;
#pragma unroll
        for (int q = 0; q < 4; ++q) { const u32x4 w = *(const u32x4*)(sp + 8 * q);
#pragma unroll
            for (int e = 0; e < 4; ++e) { const float a0 = gelu_f(bflo(w[e])), a1 = gelu_f(bfhi(w[e])); x[8 * q + 2 * e] = a0; x[8 * q + 2 * e + 1] = a1; ss += a0 * a0 + a1 * a1; } }
        ss += __shfl_xor(ss, 1); ss += __shfl_xor(ss, 2);
        const float r = rsqrtf(ss * (1.f / 128.f) + EPS); const float* gp = vng + g4 * 128 + part * 32;
#pragma unroll
        for (int q = 0; q < 4; ++q) { u32x4 w;
#pragma unroll
            for (int e = 0; e < 4; ++e) w[e] = pk2(x[8 * q + 2 * e] * r * gp[8 * q + 2 * e], x[8 * q + 2 * e + 1] * r * gp[8 * q + 2 * e + 1]);
            *(LAS u32x4*)(VN + pos * 144 + part * 32 + 8 * q) = w; }
    }
    __syncthreads();
#pragma unroll
    for (int ct = 0; ct < 8; ++ct) { f32x4 acc = {0.f, 0.f, 0.f, 0.f};
#pragma unroll
        for (int ks = 0; ks < 4; ++ks) { const LAS unsigned char* p1 = (const LAS unsigned char*)VN + (32 * ks + 8 * g + q4) * 288 + (16 * ct + 4 * pp) * 2; const bf16x8 Bf = tr2(p1, p1 + 4 * 288); acc = MFMA16(Aw[ks], Bf, acc); }
#pragma unroll
        for (int r = 0; r < 4; ++r) { const size_t tok = (size_t)(tok0 + t0 + 4 * g + r); const int cc = g4 * 128 + 16 * ct + i15;
            const float uv = bf2f(uraw[ct][r]); MX[tok * DM + 512 + cc] = (bf16)f2bf(gelu_f(uv) * (acc[r] + bsv[r])); } }
    __syncthreads();
}

__device__ __forceinline__ void mla_finalize(const bf16* QA, const bf16* KVA, const bf16* KPE, bf16* YQ, bf16* YKV, bf16* KK, const float* qn_g, const float* kn_g, int wave, int lane) {
    const int gw = blockIdx.x * 8 + wave, NGW = gridDim.x * 8;
    const float qg0 = qn_g[lane], qg1 = qn_g[64 + lane], qg2 = qn_g[128 + lane], kg0 = kn_g[lane], kg1 = kn_g[64 + lane], kg2 = kn_g[128 + lane];
    const int half = (lane >> 4) & 1; const float invf = exp2f(-(float)(lane & 15) * (13.287712379549449f / 16.0f));
    for (int tok = gw; tok < NTOK; tok += NGW) {
        bf16* qp = YQ + (size_t)tok * 1152; bf16* kvp = YKV + (size_t)tok * 1536; bf16* kp = KK + (size_t)tok * 1152;
        unsigned wq[3], wk[2];
#pragma unroll
        for (int j = 0; j < 3; ++j) wq[j] = *(const unsigned*)(QA + (size_t)tok * 384 + 2 * lane + 128 * j);
#pragma unroll
        for (int j = 0; j < 2; ++j) wk[j] = *(const unsigned*)(KVA + (size_t)tok * 256 + 2 * lane + 128 * j);
        const float kpe = bf2f(KPE[(size_t)tok * 64 + lane]);
        float y[6][3], kv[6][4];
#pragma unroll
        for (int h = 0; h < 6; ++h) { y[h][0] = bf2f(qp[h * 192 + lane]); y[h][1] = bf2f(qp[h * 192 + 64 + lane]); y[h][2] = bf2f(qp[h * 192 + 128 + lane]);
            kv[h][0] = bf2f(kvp[h * 256 + lane]); kv[h][1] = bf2f(kvp[h * 256 + 64 + lane]); kv[h][2] = bf2f(kvp[h * 256 + 128 + lane]); kv[h][3] = bf2f(kvp[h * 256 + 192 + lane]); }
        float sq = 0.f, sk = 0.f;
#pragma unroll
        for (int j = 0; j < 3; ++j) { const float a = bflo(wq[j]), b = bfhi(wq[j]); sq += a * a + b * b; }
#pragma unroll
        for (int j = 0; j < 2; ++j) { const float a = bflo(wk[j]), b = bfhi(wk[j]); sk += a * a + b * b; }
        const float rq = rsqrtf(wave_sum(sq) * (1.f / 384.f) + EPS), rk = rsqrtf(wave_sum(sk) * (1.f / 256.f) + EPS);
        float cs = 1.f, sn = 0.f;
        if (tok < NTX) { const int t = tok & 2047; const float pos = (float)((lane >> 5) ? (t & 63) : (t >> 6)); sincosf(pos * invf, &sn, &cs); }
        float sqh[6], skh[6];
#pragma unroll
        for (int h = 0; h < 6; ++h) { y[h][0] *= rq; y[h][1] *= rq; y[h][2] *= rq; kv[h][0] *= rk; kv[h][1] *= rk; kv[h][2] *= rk; kv[h][3] *= rk;
            sqh[h] = y[h][0] * y[h][0] + y[h][1] * y[h][1] + y[h][2] * y[h][2]; skh[h] = kv[h][0] * kv[h][0] + kv[h][1] * kv[h][1] + kpe * kpe; }
#pragma unroll
        for (int o = 1; o < 64; o <<= 1)
#pragma unroll
            for (int h = 0; h < 6; ++h) { sqh[h] += __shfl_xor(sqh[h], o); skh[h] += __shfl_xor(skh[h], o); }
#pragma unroll
        for (int h = 0; h < 6; ++h) {
            float r = rsqrtf(sqh[h] * (1.f / 192.f) + EPS);
            r *= 0.07216878364870322f * 1.4426950408889634f;
            float y0 = y[h][0] * r * qg0, y1 = y[h][1] * r * qg1, y2 = y[h][2] * r * qg2;
            { const float pr = __shfl_xor(y2, 16); const float rot = half ? pr : -pr; y2 = y2 * cs + rot * sn; }
            qp[h * 192 + lane] = (bf16)f2bf(y0); qp[h * 192 + 64 + lane] = (bf16)f2bf(y1); qp[h * 192 + 128 + lane] = (bf16)f2bf(y2);
            r = rsqrtf(skh[h] * (1.f / 192.f) + EPS);
            float k0 = kv[h][0] * r * kg0, k1 = kv[h][1] * r * kg1, k2 = kpe * r * kg2;
            { const float pr = __shfl_xor(k2, 16); const float rot = half ? pr : -pr; k2 = k2 * cs + rot * sn; }
            kp[h * 192 + lane] = (bf16)f2bf(k0); kp[h * 192 + 64 + lane] = (bf16)f2bf(k1); kp[h * 192 + 128 + lane] = (bf16)f2bf(k2);
            kvp[h * 256 + 128 + lane] = (bf16)f2bf(kv[h][2]); kvp[h * 256 + 192 + lane] = (bf16)f2bf(kv[h][3]);
        }
    }
}

__device__ __forceinline__ unsigned cvtpk(float lo, float hi) { unsigned r; asm("v_cvt_pk_bf16_f32 %0, %1, %2" : "=v"(r) : "v"(lo), "v"(hi)); return r; }
__device__ __forceinline__ void attn_unit(int unit, const bf16* Q, const bf16* KK, const bf16* YKV, bf16* MX, LAS unsigned char* L, int tid, int wave, int lane) {
    int b, h, qtok0, ntiles;
    if (unit < 384) { b = unit / 48; h = (unit >> 3) % 6; qtok0 = b * 2048 + (unit & 7) * 256; ntiles = 36; }
    else { const int u2 = unit - 384; b = u2 / 6; h = u2 % 6; qtok0 = NTX + b * 256; ntiles = 4; }
    const int g = lane >> 4, i15 = lane & 15, q4 = i15 >> 2, pp = i15 & 3;
    bf16x8 qf[2][6];
#pragma unroll
    for (int r = 0; r < 2; ++r) { const bf16* qp = Q + (size_t)(qtok0 + 32 * wave + 16 * r + i15) * 1152 + h * 192 + 8 * g;
#pragma unroll
      for (int ks = 0; ks < 6; ++ks) qf[r][ks] = *(const bf16x8*)(qp + 32 * ks); }
    int koff, voff;
    { const int r = 8 * wave + (lane >> 3), c = (lane & 7) ^ ((r >> 1) & 7); koff = r * 1152 + h * 192 + c * 8; }
    { const int r = 4 * wave + (lane >> 4), sl = lane & 15, dt = (sl >> 1) ^ (r & 7), c = 2 * dt + (sl & 1); voff = r * 1536 + h * 256 + 128 + c * 8; }
#define ATT_ISSUE(j, slot) do { const int kt0_ = (j) < 4 ? NTX + b * 256 + 64 * (j) : b * 2048 + 64 * ((j) - 4); \
        const bf16* kg_ = KK + (size_t)kt0_ * 1152 + koff; const bf16* vg_ = YKV + (size_t)kt0_ * 1536 + voff; LAS unsigned char* lb_ = L + (slot) * 40960 + wave * 1024; \
        __builtin_amdgcn_global_load_lds((const unsigned*)kg_, (LAS unsigned*)lb_, 16, 0, 0); \
        __builtin_amdgcn_global_load_lds((const unsigned*)(kg_ + 64), (LAS unsigned*)(lb_ + 8192), 16, 0, 0); \
        __builtin_amdgcn_global_load_lds((const unsigned*)(kg_ + 128), (LAS unsigned*)(lb_ + 16384), 16, 0, 0); \
        __builtin_amdgcn_global_load_lds((const unsigned*)vg_, (LAS unsigned*)(lb_ + 24576), 16, 0, 0); \
        __builtin_amdgcn_global_load_lds((const unsigned*)(vg_ + 32 * 1536), (LAS unsigned*)(lb_ + 24576 + 8192), 16, 0, 0); } while (0)
    const int kx = i15 >> 1, ka0 = i15 * 128 + ((g ^ kx) * 16), ka1 = i15 * 128 + (((4 + g) ^ kx) * 16);
    const int vbase = (4 * g + q4) * 256 + 8 * pp + ((4 * (g & 1) + q4) * 32);
    ATT_ISSUE(0, 0);
    f32x4 oacc[2][8];
#pragma unroll
    for (int r = 0; r < 2; ++r)
#pragma unroll
        for (int dt = 0; dt < 8; ++dt) oacc[r][dt] = (f32x4){0.f, 0.f, 0.f, 0.f};
    float mrun[2] = {0.f, 0.f}; f32x4 lacc[2] = {(f32x4){0.f, 0.f, 0.f, 0.f}, (f32x4){0.f, 0.f, 0.f, 0.f}};
    const bf16x8 ones = {16256, 16256, 16256, 16256, 16256, 16256, 16256, 16256};
    for (int j = 0; j < ntiles; ++j) {
        asm volatile("s_waitcnt vmcnt(0)" ::: "memory");
        __syncthreads();
        if (j + 1 < ntiles) ATT_ISSUE(j + 1, (j + 1) & 1);
        const LAS unsigned char* Kb = L + (j & 1) * 40960; const LAS unsigned char* Vb = Kb + 24576;
        f32x4 s[2][4];
#pragma unroll
        for (int T = 0; T < 4; ++T) { s[0][T] = (f32x4){-mrun[0], -mrun[0], -mrun[0], -mrun[0]}; s[1][T] = (f32x4){-mrun[1], -mrun[1], -mrun[1], -mrun[1]}; }
#define KFRAG(T_, ks_) (*(const LAS bf16x8*)(Kb + ((ks_) >> 1) * 8192 + (T_) * 2048 + (((ks_) & 1) ? ka1 : ka0)))
        bf16x8 kc[3], kn[3];
        kc[0] = KFRAG(0, 0); kc[1] = KFRAG(0, 1); kc[2] = KFRAG(0, 2);
#pragma unroll
        for (int hb = 0; hb < 8; ++hb) { const int T = hb >> 1, k0 = (hb & 1) * 3;
            if (hb < 7) { const int T2 = (hb + 1) >> 1, k2 = ((hb + 1) & 1) * 3; kn[0] = KFRAG(T2, k2); kn[1] = KFRAG(T2, k2 + 1); kn[2] = KFRAG(T2, k2 + 2); }
            __builtin_amdgcn_sched_barrier(0);
#pragma unroll
            for (int i = 0; i < 3; ++i) { s[0][T] = MFMA16(kc[i], qf[0][k0 + i], s[0][T]); s[1][T] = MFMA16(kc[i], qf[1][k0 + i], s[1][T]); }
            __builtin_amdgcn_sched_barrier(0);
            kc[0] = kn[0]; kc[1] = kn[1]; kc[2] = kn[2]; }
#undef KFRAG
#define VFRAG(dt_, k2_) tr2(Vb + (k2_) * 8192 + (vbase ^ ((dt_) << 5)), Vb + (k2_) * 8192 + (vbase ^ ((dt_) << 5)) + 4096)
        bf16x8 vc[2], vn[2];
        vc[0] = VFRAG(0, 0); vc[1] = VFRAG(0, 1);
        bf16x8 pf[2][2]; float mxr[2];
#pragma unroll
        for (int r = 0; r < 2; ++r) {
            float mx = s[r][0][0];
#pragma unroll
            for (int T = 0; T < 4; ++T)
#pragma unroll
                for (int e = 0; e < 4; ++e) mx = fmaxf(mx, s[r][T][e]);
            mx = fmaxf(mx, __shfl_xor(mx, 16)); mx = fmaxf(mx, __shfl_xor(mx, 32)); mxr[r] = mx;
        }
        if (__any((mxr[0] > 8.0f) || (mxr[1] > 8.0f))) {
#pragma unroll
            for (int r = 0; r < 2; ++r) { const float d = mxr[r] > 8.0f ? mxr[r] : 0.f, al = __builtin_amdgcn_exp2f(-d); mrun[r] += d;
#pragma unroll
                for (int T = 0; T < 4; ++T) s[r][T] = s[r][T] - d;
#pragma unroll
                for (int dt = 0; dt < 8; ++dt) oacc[r][dt] = oacc[r][dt] * al;
                lacc[r] = lacc[r] * al; }
        }
#pragma unroll
        for (int r = 0; r < 2; ++r) { u32x4 pw[2];
#pragma unroll
            for (int T = 0; T < 4; ++T) { float p[4];
#pragma unroll
                for (int e = 0; e < 4; ++e) p[e] = __builtin_amdgcn_exp2f(s[r][T][e]);
                pw[T >> 1][2 * (T & 1)] = cvtpk(p[0], p[1]); pw[T >> 1][2 * (T & 1) + 1] = cvtpk(p[2], p[3]); }
            pf[r][0] = __builtin_bit_cast(bf16x8, pw[0]); pf[r][1] = __builtin_bit_cast(bf16x8, pw[1]);
            lacc[r] = MFMA16(ones, pf[r][0], lacc[r]); lacc[r] = MFMA16(ones, pf[r][1], lacc[r]);
        }
#pragma unroll
        for (int dt = 0; dt < 8; ++dt) {
            if (dt < 7) { vn[0] = VFRAG(dt + 1, 0); vn[1] = VFRAG(dt + 1, 1); }
            __builtin_amdgcn_sched_barrier(0);
            oacc[0][dt] = MFMA16(vc[0], pf[0][0], oacc[0][dt]); oacc[1][dt] = MFMA16(vc[0], pf[1][0], oacc[1][dt]);
            oacc[0][dt] = MFMA16(vc[1], pf[0][1], oacc[0][dt]); oacc[1][dt] = MFMA16(vc[1], pf[1][1], oacc[1][dt]);
            __builtin_amdgcn_sched_barrier(0);
            vc[0] = vn[0]; vc[1] = vn[1]; }
#undef VFRAG
    }
#undef ATT_ISSUE
#pragma unroll
    for (int r = 0; r < 2; ++r) { const float inv = 1.f / lacc[r][0];
        bf16* op = MX + (size_t)(qtok0 + 32 * wave + 16 * r + i15) * DM + 256 + h * 128 + 4 * g;
#pragma unroll
        for (int dt = 0; dt < 8; ++dt) { u32x2 o; o.x = cvtpk(oacc[r][dt][0] * inv, oacc[r][dt][1] * inv); o.y = cvtpk(oacc[r][dt][2] * inv, oacc[r][dt][3] * inv); *(u32x2*)(op + 16 * dt) = o; } }
    __syncthreads();
}

#ifndef REP_PRO
#define REP_PRO 1
#endif
#ifndef REP_NORM
#define REP_NORM 1
#endif
#ifndef REP_G1
#define REP_G1 1
#endif
#ifndef REP_GLA
#define REP_GLA 1
#endif
#ifndef REP_GLAC
#define REP_GLAC 1
#endif
#ifndef REP_G2
#define REP_G2 1
#endif
#ifndef REP_G3
#define REP_G3 1
#endif
#ifndef REP_FIN
#define REP_FIN 1
#endif
#ifndef REP_FOUR
#define REP_FOUR 1
#endif
#ifndef REP_ATT
#define REP_ATT 1
#endif
#ifndef REP_G4L0
#define REP_G4L0 1
#endif
#ifndef REP_G4
#define REP_G4 1
#endif
#ifndef REP_G5
#define REP_G5 1
#endif
#ifndef REP_G6
#define REP_G6 1
#endif
#ifndef EXTRA_SYNCS
#define EXTRA_SYNCS 0
#endif
#ifndef EN_PRO
#define EN_PRO 1
#endif
#ifndef EN_NORM
#define EN_NORM 1
#endif
#ifndef EN_G1
#define EN_G1 1
#endif
#ifndef EN_GLA
#define EN_GLA 1
#endif
#ifndef EN_GLAC
#define EN_GLAC 1
#endif
#ifndef EN_G2
#define EN_G2 1
#endif
#ifndef EN_G3
#define EN_G3 1
#endif
#ifndef EN_FIN
#define EN_FIN 1
#endif
#ifndef EN_FOUR
#define EN_FOUR 1
#endif
#ifndef EN_ATT
#define EN_ATT 1
#endif
#ifndef EN_G4
#define EN_G4 1
#endif
#ifndef EN_G5
#define EN_G5 1
#endif
#ifndef EN_G6
#define EN_G6 1
#endif

constexpr int N_PHASES = 37;
__device__ __forceinline__ bool in_phase(LAS unsigned char* L, int k) { const LAS unsigned* p = (const LAS unsigned*)(L + 131072) + 58; const int lo = (int)__builtin_amdgcn_readfirstlane(p[0]), hi = (int)__builtin_amdgcn_readfirstlane(p[1]); return lo <= k && k < hi; }
__global__ void __launch_bounds__(512, 2) mk_fwd(Args a) {
    extern __shared__ __attribute__((aligned(16))) unsigned char lds_raw[];
    LAS unsigned char* L = (LAS unsigned char*)lds_raw;
    cg::grid_group grid = cg::this_grid();
    { const int tid = threadIdx.x;
    if (tid < 29) { const unsigned long long v = tid < 27 ? (unsigned long long)a.in[tid] : (tid == 27 ? (unsigned long long)a.out : (unsigned long long)a.ws);
        ((LAS unsigned*)(L + 131072))[2 * tid] = (unsigned)v; ((LAS unsigned*)(L + 131072))[2 * tid + 1] = (unsigned)(v >> 32); } }
    if (threadIdx.x == 0) { ((LAS unsigned*)(L + 131072))[58] = (unsigned)a.ph_lo; ((LAS unsigned*)(L + 131072))[59] = (unsigned)a.ph_hi; }
    if (threadIdx.x < 2) ((LAS unsigned*)(L + 131072 + 512))[threadIdx.x] = 0u;
    __syncthreads();
    (void)xcd_barrier_post((unsigned*)a.ws, (volatile LAS unsigned*)(L + 131072 + 512));
    const bool lo_dead = a.ph_lo < 0;
#define IN(k) in_phase(L, (k))
#define SEAM(k) do { if (IN(k) && IN((k) + 1)) { if (lo_dead) grid.sync(); else { XcdBarrier xb_; xb_.bar = (unsigned*)WSP; xb_.x = xb_xcc_id(); xb_.st = (volatile LAS unsigned*)(L + 131072 + 512); xcd_barrier(xb_); for (int xs_ = 0; xs_ < EXTRA_SYNCS; ++xs_) xcd_barrier(xb_); } } } while (0)
#define TID_VARS int tid = threadIdx.x; asm volatile("" : "+v"(tid)); const int lane = tid & 63, wave = __builtin_amdgcn_readfirstlane(tid >> 6); (void)lane; (void)wave;
#define LAYER_VARS TID_VARS int l = lc; asm volatile("" : "+s"(l)); const int i2 = l >> 1; const bool need_ctx = l < 3; const int mtok = need_ctx ? NTOK : NTX; unsigned char* ws = WSP; const int G = gridDim.x, bid = blockIdx.x; \
        float* MOD = (float*)(ws + WS_MOD); const float* mod = MOD + (size_t)l * 9 * 6144; bf16* ZX = (bf16*)(ws + WS_ZX); float* HB = (float*)(ws + WS_H); (void)i2; (void)need_ctx; (void)mtok; (void)G; (void)bid; (void)mod; (void)ZX; (void)HB;
    for (int rep_ = 0; rep_ < REP_PRO; ++rep_) if (EN_PRO && IN(0)) { TID_VARS prologue(L, tid, wave, lane); }
    SEAM(0);
#pragma nounroll
    for (int lc = 0; lc < 4; ++lc) {
        const int p0 = 1 + 9 * lc; const bool odd = lc & 1;
        for (int rep_ = 0; rep_ < REP_NORM; ++rep_) if (EN_NORM && IN(p0)) { LAYER_VARS const float* xin = l == 0 ? INP(0) : OUTP; const float* hin = l == 0 ? INP(2) : HB; norm_phase(xin, hin, INP(6) + l * DM, mod, 0, 1, ZX, NTOK, wave, lane, l > 0 ? (const bf16*)(ws + WS_R2) : nullptr, HB); }
        SEAM(p0);
        if (!odd) {
            for (int rep_ = 0; rep_ < REP_G1; ++rep_) if (EN_G1 && IN(p0 + 1)) { LAYER_VARS bf16* P = (bf16*)(ws + WS_R1);
                pg8::Gemm g{ZX, (const bf16*)(ws + WS_WEV) + (size_t)i2 * EVP * 1024, NTOK, EVP, 1024}; pg8::StaticOrder S; S.init(NTOK, EVP, G, bid);
                EpiStore E{P, EVW, EVW}; pg8::gemm_phase<EpiStore, pg8::StaticOrder, true, true>(L, g, S, E); }
            SEAM(p0 + 1);
            for (int rep_ = 0; rep_ < REP_GLA; ++rep_) if (EN_GLA && IN(p0 + 2)) { LAYER_VARS bf16* P = (bf16*)(ws + WS_R1); bf16* U = (bf16*)(ws + WS_R2 + R2_U); float* DD = (float*)(ws + WS_R2 + R2_DD);
                const float *waf = INP(12) + i2 * 4096, *baf = INP(13) + i2 * 256, *wab = INP(14) + i2 * 4096, *bab = INP(15) + i2 * 256;
                for (int u = bid; u < 1152 + 576; u += G) {
                    if (u < 1152) gla_passA(u, P, waf, baf, wab, bab, U, DD, L, tid, wave, lane);
                    else sg_unit(u - 1152, P, INP(17) + i2 * 512, (const bf16*)(ws + WS_SGW) + (size_t)i2 * 65536, INP(19) + i2 * 512, ZX, L, tid, wave, lane);
                } }
            SEAM(p0 + 2);
            for (int rep_ = 0; rep_ < REP_GLA; ++rep_) if (EN_GLA && IN(p0 + 3)) { LAYER_VARS gla_passB((const bf16*)(ws + WS_R2 + R2_U), (const float*)(ws + WS_R2 + R2_DD), (bf16*)(ws + WS_R2 + R2_SB), tid); }
            SEAM(p0 + 3);
            for (int rep_ = 0; rep_ < REP_GLAC; ++rep_) if (EN_GLAC && IN(p0 + 4)) { LAYER_VARS bf16* P = (bf16*)(ws + WS_R1); const bf16* SB = (const bf16*)(ws + WS_R2 + R2_SB);
                const float *waf = INP(12) + i2 * 4096, *baf = INP(13) + i2 * 256, *wab = INP(14) + i2 * 4096, *bab = INP(15) + i2 * 256;
                if (bid < 1152) { GlaPre cur = gla_pre_load(bid, P, waf, baf, wab, bab, tid);
#pragma nounroll
                    for (int u = bid; u < 1152; u += G) { GlaPre nxt = cur; if (u + G < 1152) nxt = gla_pre_load(u + G, P, waf, baf, wab, bab, tid);
                        gla_passC(u, cur, P, SB, INP(16) + i2 * 128, ZX, L, tid, wave, lane); cur = nxt; } } }
            SEAM(p0 + 4);
        } else {
            for (int rep_ = 0; rep_ < REP_G2; ++rep_) if (EN_G2 && IN(p0 + 1)) { LAYER_VARS
                pg8::Gemm g{ZX, (const bf16*)(ws + WS_WOD) + (size_t)i2 * ODP * 1024, NTOK, ODP, 1024}; pg8::StaticOrder S; S.init(NTOK, ODP, G, bid);
                EpiOddIn E{(bf16*)(ws + WS_R1 + R1_QA), (bf16*)(ws + WS_R1 + R1_KVA), (bf16*)(ws + WS_R1 + R1_KPE), (bf16*)(ws + WS_R1 + R1_FBX), (bf16*)(ws + WS_R1 + R1_FBC)};
                pg8::gemm_phase<EpiOddIn, pg8::StaticOrder, true, true>(L, g, S, E); }
            SEAM(p0 + 1);
            for (int rep_ = 0; rep_ < REP_G3; ++rep_) if (EN_G3 && IN(p0 + 2)) {
#pragma nounroll
                for (int wq = 0; wq < 2; ++wq) { LAYER_VARS int w = wq; asm volatile("" : "+s"(w));
                    const bf16* A = (const bf16*)(ws + WS_R1 + (w ? R1_KVA : R1_QA)); const bf16* Bt = w ? (const bf16*)(ws + WS_WUKV) + (size_t)i2 * 1536 * 256 : (const bf16*)(ws + WS_WUQ) + (size_t)i2 * 1280 * 384;
                    const int Kk = w ? 256 : 384, Np = w ? 1536 : 1280, Nv = w ? 1536 : 1152; bf16* O = w ? (bf16*)(ws + WS_R2 + R2_YKV) : (bf16*)(ws + WS_R1 + R1_YQ);
                    pg8::Gemm g{A, Bt, NTOK, Np, Kk}; pg8::StaticOrder S; S.init(NTOK, Np, G, bid);
                    EpiStore E{O, Nv, Nv}; pg8::gemm_phase<EpiStore, pg8::StaticOrder, true, true>(L, g, S, E); } }
            SEAM(p0 + 2);
            for (int rep_ = 0; rep_ < REP_FIN; ++rep_) if (EN_FIN && IN(p0 + 3)) { LAYER_VARS mla_finalize((bf16*)(ws + WS_R1 + R1_QA), (bf16*)(ws + WS_R1 + R1_KVA), (bf16*)(ws + WS_R1 + R1_KPE), (bf16*)(ws + WS_R1 + R1_YQ), (bf16*)(ws + WS_R2 + R2_YKV), (bf16*)(ws + WS_R2 + R2_KK), INP(25) + i2 * 192, INP(26) + i2 * 192, wave, lane); }
            SEAM(p0 + 3);
            for (int rep_ = 0; rep_ < REP_FOUR; ++rep_) if (EN_FOUR && IN(p0 + 4)) {
#pragma nounroll
                for (int wq = 0; wq < 2; ++wq) { LAYER_VARS int w = wq; asm volatile("" : "+s"(w)); const int NF = G >= 128 ? 64 : G;
                    if (bid < NF && (w == 0 || need_ctx)) {
                        const bf16* A = (const bf16*)(ws + (w ? WS_DFTC : WS_DFTX)); const bf16* Bt = (const bf16*)(ws + WS_R1 + (w ? R1_FBC : R1_FBX));
                        const int Mm = w ? 256 : 2048, Kk = w ? 512 : 4096;
                        pg8::Gemm g{A, Bt, Mm, 2048, Kk}; pg8::StaticOrder S; S.init(Mm, 2048, NF, bid);
                        EpiFourier E{ZX, w ? NTX : 0, Mm, w ? 0.0078125f : 0.00276213586400995f}; pg8::gemm_phase<EpiFourier, pg8::StaticOrder, true, true>(L, g, S, E); } } }
            for (int rep_ = 0; rep_ < REP_ATT; ++rep_) if (EN_ATT && IN(p0 + 4)) { LAYER_VARS const int NF = G >= 128 ? 64 : 0, GA = G - NF, ba = bid - NF;
                const int nun = need_ctx ? 432 : 384;
                if (ba >= 0) for (int v = ba; v < nun; v += GA) { int u = v;
                    if (G == 256) { const int x = v & 7, li = (v % 192) >> 3, i = v / 192; if (i < 2) { const int lu = li + 24 * i; u = (x + 8 * (lu >> 3)) * 8 + (lu & 7); } else u = 384 + x + 8 * li; }
                    attn_unit(u, (bf16*)(ws + WS_R1 + R1_YQ), (bf16*)(ws + WS_R2 + R2_KK), (bf16*)(ws + WS_R2 + R2_YKV), ZX, L, tid, wave, lane); } }
            SEAM(p0 + 4);
        }
        for (int rep_ = 0; rep_ < (lc == 0 ? REP_G4L0 : REP_G4); ++rep_) if (EN_G4 && IN(p0 + 5)) { LAYER_VARS const float* xin = l == 0 ? INP(0) : OUTP; const float* hin = l == 0 ? INP(2) : HB;
            pg8::Gemm g{ZX, (const bf16*)(ws + WS_WMIX) + (size_t)l * DM * DM, mtok, DM, DM};
            pg8::TailOrder S; S.init(DM, G, bid, need_ctx ? 256 : 0); EpiResid E{xin, hin, OUTP, HB, mod + 2 * 1024, (bf16*)(ws + WS_R2)}; pg8::gemm_phase<EpiResid, pg8::TailOrder, true, true>(L, g, S, E); }
        SEAM(p0 + 5);
        for (int rep_ = 0; rep_ < REP_NORM; ++rep_) if (EN_NORM && IN(p0 + 6)) { LAYER_VARS { const float* hin = l == 0 ? INP(2) : HB; norm_phase(OUTP, hin, INP(7) + l * DM, mod, 3, 4, ZX, mtok, wave, lane, need_ctx ? (const bf16*)(ws + WS_R2) : nullptr, HB); } }
        SEAM(p0 + 6);
        for (int rep_ = 0; rep_ < REP_G5; ++rep_) if (EN_G5 && IN(p0 + 7)) { LAYER_VARS
            pg8::Gemm g{ZX, (const bf16*)(ws + WS_WFI) + (size_t)l * 5632 * 1024, mtok, 5632, 1024}; pg8::StaticOrder S; S.init(mtok, 5632, G, bid);
            EpiSwiglu E{(bf16*)(ws + WS_R1)}; pg8::gemm_phase<EpiSwiglu, pg8::StaticOrder, true, true>(L, g, S, E); }
        SEAM(p0 + 7);
        for (int rep_ = 0; rep_ < REP_G6; ++rep_) if (EN_G6 && IN(p0 + 8)) { LAYER_VARS float* outp = OUTP;
            pg8::Gemm g{(bf16*)(ws + WS_R1), (const bf16*)(ws + WS_WFO) + (size_t)l * DM * FF, mtok, DM, FF};
            pg8::TailOrder S; S.init(FF, G, bid, need_ctx ? 256 : 0); EpiResid E{outp, HB, outp, HB, mod + 5 * 1024, (bf16*)(ws + WS_R2)}; pg8::gemm_phase<EpiResid, pg8::TailOrder, true, true>(L, g, S, E); }
        SEAM(p0 + 8);
    }
#undef IN
#undef SEAM
}

#ifndef MK_PER_PHASE
#define MK_PER_PHASE 0
#endif
extern "C" void kernel_launch(void* const* d_in, const int* in_sizes, int n_in, void* d_out, int out_size, void* d_ws, size_t ws_size, hipStream_t stream) {
    static int grid = 0;
    if (grid == 0) {
        if (n_in != 27 || ws_size < WS_END) { fprintf(stderr, "kernel_launch: need 27 inputs and >= %zu bytes of workspace (got %d, %zu)\n", (size_t)WS_END, n_in, ws_size); grid = -1; return; }
        int dev = 0, cus = 0, per_cu = 0;
        hipGetDevice(&dev); hipDeviceGetAttribute(&cus, hipDeviceAttributeMultiprocessorCount, dev);
        if (hipFuncSetAttribute((const void*)mk_fwd, hipFuncAttributeMaxDynamicSharedMemorySize, LDS_BYTES) != hipSuccess) { fprintf(stderr, "kernel_launch: hipFuncSetAttribute failed\n"); grid = -1; return; }
        if (hipOccupancyMaxActiveBlocksPerMultiprocessor(&per_cu, (const void*)mk_fwd, 512, LDS_BYTES) != hipSuccess || per_cu < 1) { fprintf(stderr, "kernel_launch: occupancy query says %d\n", per_cu); per_cu = 1; }
        (void)hipGetLastError();
        grid = cus * 1;
    }
    if (grid < 0) return;
    if (hipMemsetAsync(d_ws, 0, 16384, stream) != hipSuccess) { fprintf(stderr, "kernel_launch: memset of the barrier words failed\n"); return; }
    Args a{};
    for (int i = 0; i < 27; ++i) a.in[i] = (const float*)d_in[i];
    a.out = (float*)d_out; a.ws = (unsigned char*)d_ws;
#if MK_PER_PHASE
    for (int p = 0; p < N_PHASES; ++p) { a.ph_lo = p; a.ph_hi = p + 1; hipLaunchKernelGGL(mk_fwd, dim3(grid), dim3(512), LDS_BYTES, stream, a); }
#else
    a.ph_lo = 0; a.ph_hi = N_PHASES;
    void* args[] = {&a};
    hipError_t e = hipLaunchCooperativeKernel((const void*)mk_fwd, dim3(grid), dim3(512), args, LDS_BYTES, stream);
    if (e != hipSuccess) fprintf(stderr, "kernel_launch: cooperative launch failed: %s (grid %d)\n", hipGetErrorString(e), grid);
#endif
}
```
